# Optimizing an MI355X kernel written in HIP

```python
import jax, jax.numpy as jnp
from jax import lax
import numpy as np

D_MODEL = 1024
BATCH = 8
SEQ = 8192
DEPTH = 2

MIX_WIDTH = D_MODEL
N_MIXERS = 4
GROUP_WIDTH = MIX_WIDTH // N_MIXERS
HEAD_DIM = 64
HEADS_PER_GROUP = GROUP_WIDTH // HEAD_DIM
CONV_WIDTH = 3
POOL_WINDOWS = (2, 4, 8, 16)
POOL_CH = GROUP_WIDTH // len(POOL_WINDOWS)
CHUNK = 128
D_FF = -(-8 * D_MODEL // (3 * 256)) * 256
N_PROJ_SLICES = 7
PROJ_WIDTH = N_PROJ_SLICES * GROUP_WIDTH
EPS = 1e-6

kernel_name = "hybrid_parallel_mixer_encoder"


def rmsnorm(x, g):
    xf = x.astype(jnp.float32)
    y = xf * lax.rsqrt(jnp.mean(xf * xf, axis=-1, keepdims=True) + EPS)
    return (y * g.astype(jnp.float32)).astype(x.dtype)


def layernorm_noaffine(x):
    xf = x.astype(jnp.float32)
    mu = jnp.mean(xf, axis=-1, keepdims=True)
    xc = xf - mu
    y = xc * lax.rsqrt(jnp.mean(xc * xc, axis=-1, keepdims=True) + EPS)
    return y.astype(x.dtype)


def short_conv(z, w):
    zp = jnp.pad(z, ((0, 0), (1, 1), (0, 0)))
    return zp[:, :-2] * w[0] + zp[:, 1:-1] * w[1] + zp[:, 2:] * w[2]


def multiscale_pool(p, pool_w, pool_scale):
    B, S, _ = p.shape
    pf = p.astype(jnp.float32)
    cs = jnp.concatenate([jnp.zeros_like(pf[:, :1]), jnp.cumsum(pf, axis=1)], axis=1)
    t = jnp.arange(S)
    outs = []
    for g, w in enumerate(POOL_WINDOWS):
        lo = jnp.clip(t - w // 2, 0, S)
        hi = jnp.clip(t + w // 2, 0, S)
        sl = slice(g * POOL_CH, (g + 1) * POOL_CH)
        csg = cs[..., sl]
        cnt = (hi - lo).astype(jnp.float32)[None, :, None]
        mean = (jnp.take(csg, hi, axis=1) - jnp.take(csg, lo, axis=1)) / cnt
        outs.append(mean - pf[..., sl])
    d = jnp.stack(outs, axis=2).astype(p.dtype)
    y = jnp.einsum("bsgc,gcd->bsgd", d, pool_w).reshape(B, S, GROUP_WIDTH)
    return y * pool_scale


def fourier_mix(f, fourier_w):
    B, S, _ = f.shape
    fh = f.astype(jnp.float32).reshape(B, S, HEADS_PER_GROUP, HEAD_DIM)
    spec = jnp.fft.fft2(fh, axes=(1, 3), norm="ortho").real.astype(f.dtype)
    return jnp.einsum("bshc,hcd->bshd", spec, fourier_w).reshape(B, S, GROUP_WIDTH)


def spatial_gate(u, v, spatial_w, spatial_b):
    B, S, _ = u.shape
    n = S // CHUNK
    vh = layernorm_noaffine(v.reshape(B, S, HEADS_PER_GROUP, HEAD_DIM))
    vh = vh.reshape(B, n, CHUNK, HEADS_PER_GROUP, HEAD_DIM)
    s = jnp.einsum("hpq,bnqhc->bnphc", spatial_w, vh) + spatial_b.T[None, None, :, :, None]
    return u * s.reshape(B, S, GROUP_WIDTH)


def hybrid_mixer(h, w_in, conv_w, pool_w, pool_scale, fourier_w, spatial_w, spatial_b,
                 group_norm_gain, w_out):
    B, S, _ = h.shape
    proj = h @ w_in
    b_gate, c_gate, z, p, f, u, v = jnp.split(proj, N_PROJ_SLICES, axis=-1)
    y_conv = b_gate * short_conv(c_gate * z, conv_w)
    y_pool = multiscale_pool(p, pool_w, pool_scale)
    y_four = fourier_mix(f, fourier_w)
    y_gmlp = spatial_gate(u, v, spatial_w, spatial_b)
    y = jnp.stack([y_conv, y_pool, y_four, y_gmlp], axis=2)
    y = rmsnorm(y, group_norm_gain.reshape(N_MIXERS, GROUP_WIDTH)).reshape(B, S, MIX_WIDTH)
    return y @ w_out


def swiglu(h, w_gate, w_up, w_down):
    return (jax.nn.silu(h @ w_gate) * (h @ w_up)) @ w_down


def setup_inputs(seed: int = 0) -> dict:
    key = jax.random.key(seed)
    ks = jax.random.split(key, 17)

    def nrm(k, shape, scale):
        return jax.random.normal(k, shape, jnp.float32) * scale

    def gain(k, shape):
        return 1.0 + nrm(k, shape, 0.05)

    return {
        "x": nrm(ks[0], (BATCH, SEQ, D_MODEL), 1.0),
        "pre_mix_gain": gain(ks[1], (DEPTH, D_MODEL)),
        "post_mix_gain": gain(ks[2], (DEPTH, D_MODEL)),
        "pre_ffn_gain": gain(ks[3], (DEPTH, D_MODEL)),
        "post_ffn_gain": gain(ks[4], (DEPTH, D_MODEL)),
        "w_in": nrm(ks[5], (DEPTH, D_MODEL, PROJ_WIDTH), D_MODEL ** -0.5),
        "conv_w": nrm(ks[6], (DEPTH, CONV_WIDTH, GROUP_WIDTH), CONV_WIDTH ** -0.5),
        "pool_w": nrm(ks[7], (DEPTH, len(POOL_WINDOWS), POOL_CH, POOL_CH), POOL_CH ** -0.5),
        "pool_scale": gain(ks[8], (DEPTH, GROUP_WIDTH)),
        "fourier_w": nrm(ks[9], (DEPTH, HEADS_PER_GROUP, HEAD_DIM, HEAD_DIM), HEAD_DIM ** -0.5),
        "spatial_w": nrm(ks[10], (DEPTH, HEADS_PER_GROUP, CHUNK, CHUNK), CHUNK ** -0.5),
        "spatial_b": 1.0 + nrm(ks[11], (DEPTH, HEADS_PER_GROUP, CHUNK), 0.02),
        "group_norm_gain": gain(ks[12], (DEPTH, MIX_WIDTH)),
        "w_out": nrm(ks[13], (DEPTH, MIX_WIDTH, D_MODEL), MIX_WIDTH ** -0.5),
        "w_gate": nrm(ks[14], (DEPTH, D_MODEL, D_FF), D_MODEL ** -0.5),
        "w_up": nrm(ks[15], (DEPTH, D_MODEL, D_FF), D_MODEL ** -0.5),
        "w_down": nrm(ks[16], (DEPTH, D_FF, D_MODEL), D_FF ** -0.5),
    }


def reference(x, pre_mix_gain, post_mix_gain, pre_ffn_gain, post_ffn_gain, w_in, conv_w,
              pool_w, pool_scale, fourier_w, spatial_w, spatial_b, group_norm_gain, w_out,
              w_gate, w_up, w_down):
    for l in range(DEPTH):
        h = rmsnorm(x, pre_mix_gain[l])
        m = hybrid_mixer(h, w_in[l], conv_w[l], pool_w[l], pool_scale[l], fourier_w[l],
                         spatial_w[l], spatial_b[l], group_norm_gain[l], w_out[l])
        x = x + rmsnorm(m, post_mix_gain[l])
        h = rmsnorm(x, pre_ffn_gain[l])
        f = swiglu(h, w_gate[l], w_up[l], w_down[l])
        x = x + rmsnorm(f, post_ffn_gain[l])
    return x
```

```cpp
#include <hip/hip_runtime.h>
#include <hip/hip_cooperative_groups.h>
#include <cstdio>
#include <cstdint>
namespace cg = cooperative_groups;
#ifndef DUPSTORE
#define DUPSTORE 0
#endif
namespace pg8 {
#define PG8_LAS __attribute__((address_space(3)))
typedef unsigned short bf16_t;
typedef short bf16x8 __attribute__((ext_vector_type(8)));
typedef float f32x4 __attribute__((ext_vector_type(4)));
typedef unsigned u32x4 __attribute__((ext_vector_type(4)));
constexpr int BM = 256, BK = 64, HALF = 128, HTB = HALF * BK * 2  , STAGE_BYTES = 8 * HTB, NXCD = 8, WGM = 8;

__host__ __device__ __forceinline__ int lds_byte(int r, int c) { const int st = (r >> 4) * 2 + (c >> 5), rr = r & 15, cc = c & 31, ob = rr * 64 + cc * 2; return st * 1024 + (ob ^ (((ob >> 9) & 1) << 5)); }
__host__ __device__ __forceinline__ void stage_rc(int b, int& R, int& C) { const int st = b / 1024, sb = b % 1024, swz = sb ^ (((sb >> 9) & 1) << 5); R = (st >> 1) * 16 + swz / 64; C = (st & 1) * 32 + (swz % 64) / 2; }
__host__ __device__ __forceinline__ int perm32(int rho) { const int n = rho >> 4, i = rho & 15; return 8 * (i >> 2) + 4 * n + (i & 3); }

struct Unit { int pm, pn; };
struct Gemm { const bf16_t* A; const bf16_t* Bt; int M, N, K; };

struct StaticOrder {
    int nM, nN, nwg, G, c;
    __host__ __device__ void init(int M, int N, int G_, int c_) { nM = M / BM; nN = N / BM; nwg = nM * nN; G = G_; c = c_; }
    __host__ __device__ bool next(int i, Unit& u) const {
        const long L = (long)i * G + c; if (L >= nwg) return false;
        int wgid = (int)L; { const int q = nwg / NXCD, r = nwg % NXCD, xcd = wgid % NXCD, off = wgid / NXCD; wgid = (xcd < r ? xcd * (q + 1) : r * (q + 1) + (xcd - r) * q) + off; }
        const int nig = WGM * nN, gid = wgid / nig, fm = gid * WGM, gsz = (nM - fm) < WGM ? (nM - fm) : WGM;
        u.pm = fm + ((wgid % nig) % gsz); u.pn = (wgid % nig) / gsz; return true;
    }
    __device__ __forceinline__ void a_ready(const Unit&) const {}
    __device__ __forceinline__ void done(const Unit&) const {}
};

__device__ __forceinline__ unsigned cvt_pk_bf16(float lo, float hi) { unsigned r; asm volatile("v_cvt_pk_bf16_f32 %0, %1, %2" : "=v"(r) : "v"(lo), "v"(hi)); return r; }
typedef unsigned u32x2 __attribute__((ext_vector_type(2)));
struct EpiPlain {
    static constexpr bool PERM = true, AFTER_DRAIN = false, BREMAP = true;
    bf16_t* O; int ldc; const float* rs; PG8_LAS unsigned char* xl;
    static constexpr bool HAS_RS = true;
    __device__ __forceinline__ void load_rs(const Unit& u, int wr, int fr, float (&rsv)[8]) const {
#pragma unroll
        for (int i = 0; i < 8; ++i) rsv[i] = rs[u.pm * BM + wr * 64 + fr + (i >> 2) * HALF + (i & 3) * 16]; }
    __device__ __forceinline__ void operator()(const f32x4 (&acc)[2][2][4][2], const Unit& u, int wr, int wc, int fr, int fq, const float (&rsv)[8]) const {
        PG8_LAS unsigned char* wl = xl + (wr * 4 + wc) * 2304; const int lane = fq * 16 + fr, rr = lane >> 3, cc = lane & 7;
#pragma unroll
        for (int ai = 0; ai < 2; ++ai)
#pragma unroll
            for (int m = 0; m < 4; ++m) { const float sc = rsv[ai * 4 + m];
#pragma unroll
                for (int bj = 0; bj < 2; ++bj) { const f32x4 v0 = acc[ai][bj][m][0] * sc, v1 = acc[ai][bj][m][1] * sc;
                    u32x4 w; w.x = cvt_pk_bf16(v0[0], v0[1]); w.y = cvt_pk_bf16(v0[2], v0[3]); w.z = cvt_pk_bf16(v1[0], v1[1]); w.w = cvt_pk_bf16(v1[2], v1[3]);
                    *(PG8_LAS u32x4*)(wl + fr * 144 + bj * 64 + fq * 16) = w; }
                asm volatile("s_waitcnt lgkmcnt(0)" ::: "memory");
                const u32x4 r0 = *(const PG8_LAS u32x4*)(wl + rr * 144 + cc * 16), r1 = *(const PG8_LAS u32x4*)(wl + (rr + 8) * 144 + cc * 16);
                bf16_t* gp = O + (size_t)(u.pm * BM + ai * HALF + wr * 64 + m * 16 + rr) * ldc + u.pn * BM + wc * 64 + cc * 8;
                __builtin_nontemporal_store(r0, (u32x4*)gp); __builtin_nontemporal_store(r1, (u32x4*)(gp + (size_t)8 * ldc));
                asm volatile("s_waitcnt lgkmcnt(0)" ::: "memory");
            }
    }
};
struct EpiSS {
    static constexpr bool PERM = true, AFTER_DRAIN = false, BREMAP = false;
    bf16_t* O; int ldc; float* ss;
    static constexpr bool HAS_RS = false;
    __device__ __forceinline__ void operator()(const f32x4 (&acc)[2][2][4][2], const Unit& u, int wr, int wc, int fr, int fq, const float (&rsv)[8]) const {
        const int row0 = u.pm * BM + wr * 64 + fr; const int col0 = u.pn * BM + wc * 32 + 8 * fq;
#pragma unroll
        for (int ai = 0; ai < 2; ++ai)
#pragma unroll
            for (int m = 0; m < 4; ++m) { const int row = row0 + ai * HALF + m * 16; bf16_t* rowp = O + (size_t)row * ldc + col0; float s = 0.f;
#pragma unroll
                for (int bj = 0; bj < 2; ++bj) { const f32x4 v0 = acc[ai][bj][m][0], v1 = acc[ai][bj][m][1];
                    s += (v0[0] * v0[0] + v0[1] * v0[1]) + (v0[2] * v0[2] + v0[3] * v0[3]) + (v1[0] * v1[0] + v1[1] * v1[1]) + (v1[2] * v1[2] + v1[3] * v1[3]);
                    u32x4 w; w.x = cvt_pk_bf16(v0[0], v0[1]); w.y = cvt_pk_bf16(v0[2], v0[3]); w.z = cvt_pk_bf16(v1[0], v1[1]); w.w = cvt_pk_bf16(v1[2], v1[3]);
                    *(u32x4*)(rowp + bj * HALF) = w; }
                s += __shfl_xor(s, 16); s += __shfl_xor(s, 32);
                if (fq == 0) ss[(size_t)row * 16 + u.pn * 4 + wc] = s; }
    }
};
struct EpiSwiGLU {
    static constexpr bool PERM = true, AFTER_DRAIN = false, BREMAP = false;
    bf16_t* O; int ldc; const float* rs; PG8_LAS unsigned char* xl;
    static __device__ __forceinline__ float sg(float g, float up) { return g * __builtin_amdgcn_rcpf(1.0f + __expf(-g)) * up; }
    static constexpr bool HAS_RS = true;
    __device__ __forceinline__ void load_rs(const Unit& u, int wr, int fr, float (&rsv)[8]) const {
#pragma unroll
        for (int i = 0; i < 8; ++i) rsv[i] = rs[u.pm * BM + wr * 64 + fr + (i >> 2) * HALF + (i & 3) * 16]; }
    __device__ __forceinline__ void operator()(const f32x4 (&acc)[2][2][4][2], const Unit& u, int wr, int wc, int fr, int fq, const float (&rsv)[8]) const {
        const int lane = fq * 16 + fr, rrow = 4 * wc + (lane >> 4), rcol = lane & 15;
#pragma unroll
        for (int ai = 0; ai < 2; ++ai)
#pragma unroll
            for (int m = 0; m < 4; ++m) { const float sc = rsv[ai * 4 + m]; PG8_LAS unsigned char* tb_ = xl + ((ai * 4 + m) & 1) * 8704 + wr * 4352;
                const float ce = -1.4426950408889634f * sc, s2 = sc * sc;
                const f32x4 ga = acc[ai][0][m][0], gb = acc[ai][0][m][1];
                const f32x4 ta = ga * acc[ai][1][m][0] * s2, tb = gb * acc[ai][1][m][1] * s2, xa = ga * ce, xb = gb * ce;
                f32x4 ra, rb;
#pragma unroll
                for (int e = 0; e < 4; ++e) { ra[e] = __builtin_amdgcn_rcpf(1.0f + __builtin_amdgcn_exp2f(xa[e])); rb[e] = __builtin_amdgcn_rcpf(1.0f + __builtin_amdgcn_exp2f(xb[e])); }
                const f32x4 oa = ta * ra, ob = tb * rb;
                u32x4 w; w.x = cvt_pk_bf16(oa[0], oa[1]); w.y = cvt_pk_bf16(oa[2], oa[3]); w.z = cvt_pk_bf16(ob[0], ob[1]); w.w = cvt_pk_bf16(ob[2], ob[3]);
                *(PG8_LAS u32x4*)(tb_ + fr * 272 + wc * 64 + fq * 16) = w;
                asm volatile("s_waitcnt lgkmcnt(0)" ::: "memory"); __builtin_amdgcn_s_barrier(); asm volatile("" ::: "memory");
                const u32x4 r = *(const PG8_LAS u32x4*)(tb_ + rrow * 272 + rcol * 16);
                __builtin_nontemporal_store(r, (u32x4*)(O + (size_t)(u.pm * BM + ai * HALF + wr * 64 + m * 16 + rrow) * ldc + u.pn * HALF + rcol * 8)); }
        asm volatile("s_waitcnt lgkmcnt(0)" ::: "memory");
    }
};

struct EpiFused {
    static constexpr bool PERM = true, AFTER_DRAIN = false, HAS_RS = false, BREMAP = false;
    bf16_t* XB; const float* gain; unsigned* xs; unsigned* part2; float* rs; unsigned* cnt1; unsigned* cnt2; float* out; int last; PG8_LAS unsigned char* xl;
    __device__ __forceinline__ void operator()(const f32x4 (&acc)[2][2][4][2], const Unit& u, int wr, int wc, int fr_, int fq_, const float (&rsv)[8]) const {
        int fr = fr_, fq = fq_; asm volatile("" : "+v"(fr), "+v"(fq));
        const int wid = wr * 4 + wc, lane = fq * 16 + fr;
        PG8_LAS float* P = (PG8_LAS float*)xl; PG8_LAS float* S = (PG8_LAS float*)(xl + 4096); PG8_LAS unsigned* flag = (PG8_LAS unsigned*)(xl + 5120);
#pragma unroll
        for (int ai = 0; ai < 2; ++ai)
#pragma unroll
            for (int m = 0; m < 4; ++m) { float s = 0.f;
#pragma unroll
                for (int bj = 0; bj < 2; ++bj)
#pragma unroll
                    for (int n = 0; n < 2; ++n) { const f32x4 v = acc[ai][bj][m][n]; s += (v[0] * v[0] + v[1] * v[1]) + (v[2] * v[2] + v[3] * v[3]); }
                s += __shfl_xor(s, 16); s += __shfl_xor(s, 32);
                if (fq == 0) P[(ai * HALF + wr * 64 + m * 16 + fr) * 4 + wc] = s; }
        asm volatile("s_waitcnt lgkmcnt(0)" ::: "memory"); __builtin_amdgcn_s_barrier(); asm volatile("" ::: "memory");
        const int prow = (wid & 3) * 64 + lane; const size_t slot = ((size_t)u.pm * BM + prow) * 4;
        if (wid < 4) { const float tp = (P[prow * 4 + 0] + P[prow * 4 + 1]) + (P[prow * 4 + 2] + P[prow * 4 + 3]);
            __hip_atomic_store(xs + slot + u.pn, __float_as_uint(tp), __ATOMIC_RELAXED, __HIP_MEMORY_SCOPE_AGENT); }
        asm volatile("s_waitcnt vmcnt(0)" ::: "memory");
        if (wid < 4 && lane == 0) __hip_atomic_fetch_add(cnt1 + 16 * u.pm, 1u, __ATOMIC_RELAXED, __HIP_MEMORY_SCOPE_AGENT);
        const int cb = u.pn * BM + wc * 32 + 8 * fq;
        u32x4 xw[2][4][2];
#pragma unroll
        for (int ai = 0; ai < 2; ++ai)
#pragma unroll
            for (int m = 0; m < 4; ++m)
#pragma unroll
                for (int bj = 0; bj < 2; ++bj) xw[ai][m][bj] = *(const u32x4*)(XB + ((size_t)u.pm * BM + ai * HALF + wr * 64 + m * 16 + fr) * 1024 + cb + bj * HALF);
        if (wid == 0) { unsigned sp = 0u;
            while (__hip_atomic_load(cnt1 + 16 * u.pm, __ATOMIC_RELAXED, __HIP_MEMORY_SCOPE_AGENT) < 16u) { __builtin_amdgcn_s_sleep(2); if (++sp > (1u << 20)) break; }
            __builtin_amdgcn_fence(__ATOMIC_ACQUIRE, "agent"); }
        asm volatile("s_waitcnt vmcnt(0) lgkmcnt(0)" ::: "memory"); __builtin_amdgcn_s_barrier(); asm volatile("" ::: "memory");
        if (wid < 4) { float t = 0.f;
#pragma unroll
            for (int k = 0; k < 4; ++k) t += __uint_as_float(__hip_atomic_load(xs + slot + k, __ATOMIC_RELAXED, __HIP_MEMORY_SCOPE_AGENT));
            S[prow] = rsqrtf(t * (1.0f / 1024.0f) + 1e-6f); }
        asm volatile("s_waitcnt vmcnt(0) lgkmcnt(0)" ::: "memory"); __builtin_amdgcn_s_barrier(); asm volatile("" ::: "memory");
        f32x4 g[2][2];
#pragma unroll
        for (int bj = 0; bj < 2; ++bj) { g[bj][0] = *(const f32x4*)(gain + cb + bj * HALF); g[bj][1] = *(const f32x4*)(gain + cb + bj * HALF + 4); }
#pragma unroll
        for (int ai = 0; ai < 2; ++ai)
#pragma unroll
            for (int m = 0; m < 4; ++m) { const int rl = ai * HALF + wr * 64 + m * 16 + fr; const size_t grow = (size_t)u.pm * BM + rl; const float rsm = S[rl]; float s2 = 0.f;
#pragma unroll
                for (int bj = 0; bj < 2; ++bj) { bf16_t* xp = XB + grow * 1024 + cb + bj * HALF; const u32x4 xq = xw[ai][m][bj];
                    const f32x4 a0 = acc[ai][bj][m][0] * rsm * g[bj][0], a1 = acc[ai][bj][m][1] * rsm * g[bj][1];
                    f32x4 v0, v1; v0[0] = __uint_as_float(xq.x << 16) + a0[0]; v0[1] = __uint_as_float(xq.x & 0xffff0000u) + a0[1]; v0[2] = __uint_as_float(xq.y << 16) + a0[2]; v0[3] = __uint_as_float(xq.y & 0xffff0000u) + a0[3];
                    v1[0] = __uint_as_float(xq.z << 16) + a1[0]; v1[1] = __uint_as_float(xq.z & 0xffff0000u) + a1[1]; v1[2] = __uint_as_float(xq.w << 16) + a1[2]; v1[3] = __uint_as_float(xq.w & 0xffff0000u) + a1[3];
                    s2 += (v0[0] * v0[0] + v0[1] * v0[1]) + (v0[2] * v0[2] + v0[3] * v0[3]) + (v1[0] * v1[0] + v1[1] * v1[1]) + (v1[2] * v1[2] + v1[3] * v1[3]);
                    if (!last) { u32x4 w; w.x = cvt_pk_bf16(v0[0], v0[1]); w.y = cvt_pk_bf16(v0[2], v0[3]); w.z = cvt_pk_bf16(v1[0], v1[1]); w.w = cvt_pk_bf16(v1[2], v1[3]); __builtin_nontemporal_store(w, (u32x4*)xp); }
                    else { float* op = out + grow * 1024 + cb + bj * HALF; __builtin_nontemporal_store(v0, (f32x4*)op); __builtin_nontemporal_store(v1, (f32x4*)(op + 4)); } }
                s2 += __shfl_xor(s2, 16); s2 += __shfl_xor(s2, 32);
                if (fq == 0) P[rl * 4 + wc] = s2;
                }
        if (!last) {
            asm volatile("s_waitcnt lgkmcnt(0)" ::: "memory"); __builtin_amdgcn_s_barrier(); asm volatile("" ::: "memory");
            if (wid < 4) { const float tp = (P[prow * 4 + 0] + P[prow * 4 + 1]) + (P[prow * 4 + 2] + P[prow * 4 + 3]);
                __hip_atomic_store(part2 + slot + u.pn, __float_as_uint(tp), __ATOMIC_RELAXED, __HIP_MEMORY_SCOPE_AGENT); }
            asm volatile("s_waitcnt vmcnt(0) lgkmcnt(0)" ::: "memory"); __builtin_amdgcn_s_barrier(); asm volatile("" ::: "memory");
            if (wid == 0) { unsigned old = 0u; if (lane == 0) old = __hip_atomic_fetch_add(cnt2 + 16 * u.pm, 1u, __ATOMIC_RELAXED, __HIP_MEMORY_SCOPE_AGENT);
                old = (unsigned)__builtin_amdgcn_readfirstlane((int)old);
                if (old == 3u) __builtin_amdgcn_fence(__ATOMIC_ACQUIRE, "agent");
                if (lane == 0) flag[0] = (old == 3u) ? 1u : 0u; }
            asm volatile("s_waitcnt vmcnt(0) lgkmcnt(0)" ::: "memory"); __builtin_amdgcn_s_barrier(); asm volatile("" ::: "memory");
            if (flag[0] != 0u && wid < 4) { float t = 0.f;
#pragma unroll
                for (int k = 0; k < 4; ++k) t += __uint_as_float(__hip_atomic_load(part2 + slot + k, __ATOMIC_RELAXED, __HIP_MEMORY_SCOPE_AGENT));
                rs[(size_t)u.pm * BM + prow] = rsqrtf(t * (1.0f / 1024.0f) + 1e-6f); }
        }
    }
};

template <class Epi, class Sched, bool ALIGN_EPI = false, bool SP2 = false>
__device__ __forceinline__ void gemm_phase(PG8_LAS unsigned char* lds, const Gemm g, const Sched& S, const Epi& E) {
    int tid_ = threadIdx.x; asm volatile("" : "+v"(tid_));
    const int tid = tid_, wid = __builtin_amdgcn_readfirstlane(tid >> 6), lane = tid & 63, wr = wid >> 2, wc = wid & 3, fr = lane & 15, fq = lane >> 4;
    const int K = g.K, nt = K / BK;
    unsigned voffA[2], voffB[2];
#pragma unroll
    for (int i = 0; i < 2; ++i) { int R, C; stage_rc(tid * 16 + i * 8192, R, C); const int Rb = Epi::BREMAP ? (64 * (R >> 5) + perm32(R & 31)) : (Epi::PERM ? ((R & ~31) + perm32(R & 31)) : R);
        voffA[i] = (unsigned)(R * K + C) * 2u; voffB[i] = (unsigned)(Rb * K + C) * 2u; }
    const size_t kstep = (size_t)(BK * 2);
    const size_t hstep = (size_t)HALF * K * 2;
    const size_t hstepB = Epi::BREMAP ? (size_t)32 * K * 2 : hstep;
    const size_t tstep = 2 * hstep;
    const unsigned ldsw = (unsigned)wid * 1024u;
    const int aoff = lds_byte(wr * 64 + fr, fq * 8), boff = lds_byte(wc * 32 + fr, fq * 8);
#define PG8_SA(b, h) (((b) * 2 + (h)) * HTB)
#define PG8_SB(b, h) ((4 + (b) * 2 + (h)) * HTB)
#define PG8_STAGE(bufoff, gbase, voff) do { _Pragma("unroll") for (int _i = 0; _i < 2; ++_i) \
        __builtin_amdgcn_global_load_lds((const unsigned*)((const char*)(gbase) + (voff)[_i]), (PG8_LAS unsigned*)(lds + (bufoff) + ldsw + _i * 8192), 16, 0, 0); } while (0)
#define PG8_LDA(dst, b, h) do { _Pragma("unroll") for (int m = 0; m < 4; ++m) _Pragma("unroll") for (int k = 0; k < 2; ++k) dst[m][k] = *(const PG8_LAS bf16x8*)(lds + PG8_SA(b, h) + aoff + m * 2048 + k * 1024); } while (0)
#define PG8_LDB(dst, b, h) do { _Pragma("unroll") for (int n = 0; n < 2; ++n) _Pragma("unroll") for (int k = 0; k < 2; ++k) dst[n][k] = *(const PG8_LAS bf16x8*)(lds + PG8_SB(b, h) + boff + n * 2048 + k * 1024); } while (0)
#define PG8_MMA(ai, bj, At, Bt) do { __builtin_amdgcn_s_setprio(1); _Pragma("unroll") for (int m = 0; m < 4; ++m) _Pragma("unroll") for (int n = 0; n < 2; ++n) _Pragma("unroll") for (int k = 0; k < 2; ++k) \
        acc[ai][bj][m][n] = __builtin_amdgcn_mfma_f32_16x16x32_bf16(Bt[n][k], At[m][k], acc[ai][bj][m][n], 0, 0, 0); __builtin_amdgcn_s_setprio(0); } while (0)
#define PG8_WAIT_V(n) asm volatile("s_waitcnt vmcnt(" #n ")" ::: "memory")
#define PG8_WAIT_L(n) asm volatile("s_waitcnt lgkmcnt(" #n ")" ::: "memory")
#define PG8_BAR __builtin_amdgcn_s_barrier()
#define PG8_SCHED __builtin_amdgcn_sched_barrier(0)
    Unit cur, nxt; int ui = 0;
    if (!S.next(0, cur)) return;
    f32x4 acc[2][2][4][2];
#pragma unroll
    for (int a = 0; a < 2; ++a)
#pragma unroll
        for (int b = 0; b < 2; ++b)
#pragma unroll
            for (int m = 0; m < 4; ++m)
#pragma unroll
                for (int n = 0; n < 2; ++n) acc[a][b][m][n] = (f32x4){0.f, 0.f, 0.f, 0.f};
    bf16x8 At[4][2], B0[2][2], B1[2][2]; float rsv[8];
#pragma unroll
    for (int i = 0; i < 8; ++i) rsv[i] = 1.0f;
    const char* cA = (const char*)g.A + (size_t)cur.pm * tstep; const char* cB = (const char*)g.Bt + (size_t)cur.pn * tstep;
    S.a_ready(cur);
    if constexpr (SP2) {
        PG8_STAGE(PG8_SB(0, 0), cB, voffB); PG8_STAGE(PG8_SB(0, 1), cB + hstepB, voffB); PG8_STAGE(PG8_SA(0, 0), cA, voffA); PG8_STAGE(PG8_SA(0, 1), cA + hstep, voffA);
        if (wr == 1) PG8_BAR;
        PG8_WAIT_V(2); PG8_BAR;
        PG8_STAGE(PG8_SB(1, 0), cB + kstep, voffB); PG8_STAGE(PG8_SA(1, 0), cA + kstep, voffA); PG8_STAGE(PG8_SB(1, 1), cB + hstepB + kstep, voffB);
        PG8_WAIT_V(6); PG8_BAR;
    } else {
        PG8_STAGE(PG8_SB(0, 0), cB, voffB); PG8_STAGE(PG8_SA(0, 0), cA, voffA); PG8_STAGE(PG8_SB(0, 1), cB + hstepB, voffB); PG8_STAGE(PG8_SA(0, 1), cA + hstep, voffA);
        if (wr == 1) PG8_BAR;
        PG8_WAIT_V(4); PG8_BAR;
        PG8_STAGE(PG8_SB(1, 0), cB + kstep, voffB); PG8_STAGE(PG8_SA(1, 0), cA + kstep, voffA); PG8_STAGE(PG8_SB(1, 1), cB + hstepB + kstep, voffB);
        PG8_WAIT_V(6); PG8_BAR;
    }
    for (;;) {
        const bool has_next = S.next(ui + 1, nxt);
        const char* nA = has_next ? (const char*)g.A + (size_t)nxt.pm * tstep : cA; const char* nB = has_next ? (const char*)g.Bt + (size_t)nxt.pn * tstep : cB;
        for (int t = 0; t < nt; t += 2) {
            const bool last = (t == nt - 2);
            const char* a1 = cA + (size_t)(t + 1) * kstep;
            const char* a2 = last ? nA : cA + (size_t)(t + 2) * kstep; const char* b2 = last ? nB : cB + (size_t)(t + 2) * kstep;
            const char* a3 = a2 + kstep; const char* b3 = b2 + kstep;
            if (last && has_next) S.a_ready(nxt);
            if constexpr (Epi::HAS_RS) { if (last) E.load_rs(cur, wr, fr, rsv); }
            if constexpr (SP2) {
            PG8_LDB(B0, 0, 0); PG8_LDB(B1, 0, 1); PG8_SCHED; PG8_LDA(At, 0, 0); PG8_STAGE(PG8_SA(1, 1), a1 + hstep, voffA);
            PG8_WAIT_V(8); PG8_WAIT_L(0); PG8_BAR; PG8_MMA(0, 0, At, B0); PG8_MMA(0, 1, At, B1); PG8_BAR; PG8_SCHED;
            PG8_LDA(At, 0, 1); PG8_STAGE(PG8_SB(0, 0), b2, voffB); PG8_STAGE(PG8_SB(0, 1), b2 + hstepB, voffB); PG8_STAGE(PG8_SA(0, 0), a2, voffA);
            PG8_WAIT_V(8); PG8_WAIT_L(0); PG8_BAR; PG8_MMA(1, 0, At, B0); PG8_MMA(1, 1, At, B1); PG8_BAR; PG8_SCHED;
            PG8_LDB(B0, 1, 0); PG8_LDB(B1, 1, 1); PG8_SCHED; PG8_LDA(At, 1, 0); PG8_STAGE(PG8_SA(0, 1), a2 + hstep, voffA);
            PG8_WAIT_V(8); PG8_WAIT_L(0); PG8_BAR; PG8_MMA(0, 0, At, B0); PG8_MMA(0, 1, At, B1); PG8_BAR; PG8_SCHED;
            PG8_LDA(At, 1, 1); PG8_STAGE(PG8_SB(1, 0), b3, voffB); PG8_STAGE(PG8_SB(1, 1), b3 + hstepB, voffB); PG8_STAGE(PG8_SA(1, 0), a3, voffA);
            PG8_WAIT_V(8); PG8_WAIT_L(0); PG8_BAR; PG8_MMA(1, 0, At, B0); PG8_MMA(1, 1, At, B1); PG8_BAR; PG8_SCHED;
            } else {
            PG8_LDB(B0, 0, 0); PG8_SCHED; PG8_LDA(At, 0, 0); PG8_STAGE(PG8_SA(1, 1), a1 + hstep, voffA);
            PG8_WAIT_L(8); PG8_BAR; PG8_WAIT_L(0); PG8_MMA(0, 0, At, B0); PG8_BAR; PG8_SCHED;
            PG8_LDB(B1, 0, 1); PG8_STAGE(PG8_SB(0, 0), b2, voffB);
            PG8_BAR; PG8_WAIT_L(0); PG8_MMA(0, 1, At, B1); PG8_BAR;
            PG8_LDA(At, 0, 1); PG8_STAGE(PG8_SA(0, 0), a2, voffA);
            PG8_BAR; PG8_WAIT_L(0); PG8_MMA(1, 0, At, B0); PG8_BAR; PG8_SCHED;
            PG8_STAGE(PG8_SB(0, 1), b2 + hstepB, voffB);
            PG8_WAIT_V(6); PG8_BAR; PG8_MMA(1, 1, At, B1); PG8_BAR;
            PG8_LDB(B0, 1, 0); PG8_SCHED; PG8_LDA(At, 1, 0); PG8_STAGE(PG8_SA(0, 1), a2 + hstep, voffA);
            PG8_WAIT_L(8); PG8_BAR; PG8_WAIT_L(0); PG8_MMA(0, 0, At, B0); PG8_BAR; PG8_SCHED;
            PG8_LDB(B1, 1, 1); PG8_STAGE(PG8_SB(1, 0), b3, voffB);
            PG8_BAR; PG8_WAIT_L(0); PG8_MMA(0, 1, At, B1); PG8_BAR;
            PG8_LDA(At, 1, 1); PG8_STAGE(PG8_SA(1, 0), a3, voffA);
            PG8_BAR; PG8_WAIT_L(0); PG8_MMA(1, 0, At, B0); PG8_BAR; PG8_SCHED;
            PG8_STAGE(PG8_SB(1, 1), b3 + hstepB, voffB);
            PG8_WAIT_V(6); PG8_BAR; PG8_MMA(1, 1, At, B1); PG8_BAR;
            }
        }
        if constexpr (ALIGN_EPI) { if (wr == 0) PG8_BAR; }
        if constexpr (!Epi::AFTER_DRAIN) { E(acc, cur, wr, wc, fr, fq, rsv); S.done(cur); }
        if (!has_next) break;
#pragma unroll
        for (int a = 0; a < 2; ++a)
#pragma unroll
            for (int b = 0; b < 2; ++b)
#pragma unroll
                for (int m = 0; m < 4; ++m)
#pragma unroll
                    for (int n = 0; n < 2; ++n) acc[a][b][m][n] = (f32x4){0.f, 0.f, 0.f, 0.f};
        cur = nxt; cA = nA; cB = nB; ++ui;
        if constexpr (ALIGN_EPI) { if (wr == 1) PG8_BAR; }
    }
    PG8_WAIT_V(0);
    if constexpr (!ALIGN_EPI) { if (wr == 0) PG8_BAR; }
    PG8_BAR;
    if constexpr (Epi::AFTER_DRAIN) { E.fused(acc, cur, wr, wc, fr, fq, lds, wid, lane); S.done(cur); }
#undef PG8_SA
#undef PG8_SB
#undef PG8_STAGE
#undef PG8_LDA
#undef PG8_LDB
#undef PG8_MMA
#undef PG8_WAIT_V
#undef PG8_WAIT_L
#undef PG8_BAR
#undef PG8_SCHED
}
}
constexpr int NWAVES = 8, NTHR = 512;
constexpr int BATCH = 8, SEQ = 8192, DM = 1024, MTOK = BATCH * SEQ, PROJ = 1792, FF = 2816, NGU = 2 * FF, DEPTH = 2;
constexpr float EPS = 1e-6f;
constexpr size_t MiB = 1u << 20, KiB = 1024;
constexpr size_t WS_CTL = 0, WS_TAB = 1 * MiB, WS_W = 4 * MiB, WS_HB = 64 * MiB, WS_PROJ = 192 * MiB, WS_Y = 416 * MiB, WS_ACT = 192 * MiB, WS_MB = 544 * MiB,
                 WS_H = 672 * MiB, WS_A = 736 * MiB, WS_SS = 770 * MiB, WS_RS = 774 * MiB, WS_XS = 775 * MiB, WS_P2 = 776 * MiB, WS_END = 777 * MiB;
constexpr int CW_CNT = 4096, CW_CNT_SET = 4096, CW_WORDS = CW_CNT + 8 * CW_CNT_SET;
constexpr size_t TAB_TT = 0, TAB_TW = 64 * KiB, TAB_L = 128 * KiB, TAB_LSTRIDE = 512 * KiB, TAB_POOLT = 0, TAB_FWT = 32 * KiB, TAB_SPW = 64 * KiB;
constexpr size_t W_LSTRIDE = 22 * MiB, W_IN = 0, W_OUT = 3 * MiB + 512 * KiB, W_GU = 5 * MiB + 512 * KiB, W_DN = 16 * MiB + 512 * KiB;
static_assert(WS_PROJ + (size_t)MTOK * PROJ * 2 == WS_Y && WS_ACT + (size_t)MTOK * FF * 2 == WS_MB && WS_W + DEPTH * W_LSTRIDE <= WS_HB, "ws map");
constexpr int LDS_BYTES = 149568;
constexpr int NPHASE = 1 + 9 * DEPTH;
#ifndef M1_REP
#define M1_REP 0
#endif
#ifndef FUSE_E
#define FUSE_E 1
#endif
#ifndef MK_SINGLE
#define MK_SINGLE 1
#endif

#define LAS __attribute__((address_space(3)))
typedef unsigned short bf16;
typedef unsigned u32x4 __attribute__((ext_vector_type(4)));
typedef unsigned u32x2 __attribute__((ext_vector_type(2)));
typedef float f32x4 __attribute__((ext_vector_type(4)));
typedef float f32x2 __attribute__((ext_vector_type(2)));
typedef short bf16x8 __attribute__((ext_vector_type(8)));

__device__ __forceinline__ unsigned f2bf(float f) { unsigned u = __float_as_uint(f); return (u + 0x7fffu + ((u >> 16) & 1u)) >> 16; }
__device__ __forceinline__ unsigned pk2(float lo, float hi) { return pg8::cvt_pk_bf16(lo, hi); }
__device__ __forceinline__ float bf_lo(unsigned w) { return __uint_as_float(w << 16); }
__device__ __forceinline__ float bf_hi(unsigned w) { return __uint_as_float(w & 0xffff0000u); }
__device__ __forceinline__ void unpack8(const u32x4 w, float (&f)[8]) { f[0] = bf_lo(w.x); f[1] = bf_hi(w.x); f[2] = bf_lo(w.y); f[3] = bf_hi(w.y); f[4] = bf_lo(w.z); f[5] = bf_hi(w.z); f[6] = bf_lo(w.w); f[7] = bf_hi(w.w); }
__device__ __forceinline__ u32x4 pack8(const float (&f)[8]) { u32x4 w; w.x = pk2(f[0], f[1]); w.y = pk2(f[2], f[3]); w.z = pk2(f[4], f[5]); w.w = pk2(f[6], f[7]); return w; }
__device__ __forceinline__ float wave_sum(float v) {
#pragma unroll
    for (int o = 1; o < 64; o <<= 1) v += __shfl_xor(v, o);
    return v;
}
#define MFMA16(a, b, c) __builtin_amdgcn_mfma_f32_16x16x32_bf16((a), (b), (c), 0, 0, 0)

struct Args { const float* in[17]; float* out; unsigned char* ws; int ph_lo, ph_hi; };

struct Ctx {
    LAS unsigned char* lds; int tid, lane, wave, G, bid;
    unsigned char* ws;
};

__device__ __forceinline__ void transpose_item(const float* W, int K, int N, int k0, int n0, bf16* WT, int dst_row0, const float* gain, LAS float* scr, int lane) {
    { const int kq = lane >> 3, nq = lane & 7; f32x4 v[8]; float g[8];
#pragma unroll
      for (int i = 0; i < 8; ++i) { v[i] = *(const f32x4*)(W + (size_t)(k0 + 8 * i + kq) * N + n0 + 4 * nq); g[i] = gain ? gain[k0 + 8 * i + kq] : 1.0f; }
#pragma unroll
      for (int i = 0; i < 8; ++i) { LAS float* d = scr + (8 * i + kq) * 33 + 4 * nq; d[0] = v[i][0] * g[i]; d[1] = v[i][1] * g[i]; d[2] = v[i][2] * g[i]; d[3] = v[i][3] * g[i]; } }
    asm volatile("s_waitcnt lgkmcnt(0)" ::: "memory");
    const int c = lane & 7;
#pragma unroll
    for (int j = 0; j < 4; ++j) { const int n = (lane >> 3) + 8 * j; const LAS float* s = scr + (8 * c) * 33 + n;
        u32x4 o; o.x = pk2(s[0 * 33], s[1 * 33]); o.y = pk2(s[2 * 33], s[3 * 33]); o.z = pk2(s[4 * 33], s[5 * 33]); o.w = pk2(s[6 * 33], s[7 * 33]);
        *(u32x4*)(WT + (size_t)(dst_row0 + n) * K + k0 + 8 * c) = o; }
    asm volatile("s_waitcnt lgkmcnt(0)" ::: "memory");
}
__device__ __forceinline__ void rms_row_to_bf16(const float* xrow, bf16* orow, float* rsp, int lane) {
    const f32x4* xr = (const f32x4*)xrow + lane; f32x4 v[4]; float s = 0.f;
#pragma unroll
    for (int j = 0; j < 4; ++j) { v[j] = xr[64 * j]; s += (v[j].x * v[j].x + v[j].y * v[j].y) + (v[j].z * v[j].z + v[j].w * v[j].w); }
    const float rs = rsqrtf(wave_sum(s) * (1.f / DM) + EPS);
    if (lane == 0) *rsp = rs;
    u32x2* o8 = (u32x2*)orow + lane;
#pragma unroll
    for (int j = 0; j < 4; ++j) { u32x2 w; w.x = pk2(v[j].x, v[j].y); w.y = pk2(v[j].z, v[j].w); o8[64 * j] = w; }
}
__device__ __forceinline__ void p_prologue(Ctx& F, const Args& AR) {
    LAS float* scr = (LAS float*)(F.lds + F.wave * 16384);
    const int gw = F.bid * NWAVES + F.wave, NGW = F.G * NWAVES;
    constexpr int I_IN = 16 * (PROJ / 32), I_OUT = 16 * (DM / 32), I_G = 16 * (FF / 32), I_D = (FF / 64) * (DM / 32), I_L = I_IN + I_OUT + 2 * I_G + I_D;
    for (int it = gw; it < DEPTH * I_L; it += NGW) {
        const int l = it / I_L; int r = it % I_L;
        bf16* wl = (bf16*)(F.ws + WS_W + (size_t)l * W_LSTRIDE);
        if (r < I_IN) { const int nb = PROJ / 32, kb = r / nb, n0 = (r % nb) * 32; transpose_item(AR.in[5] + (size_t)l * DM * PROJ, DM, PROJ, kb * 64, n0, (bf16*)((unsigned char*)wl + W_IN), n0, AR.in[1] + l * DM, scr, F.lane); continue; } r -= I_IN;
        if (r < I_OUT) { const int nb = DM / 32, kb = r / nb, n0 = (r % nb) * 32; transpose_item(AR.in[13] + (size_t)l * DM * DM, DM, DM, kb * 64, n0, (bf16*)((unsigned char*)wl + W_OUT), n0, AR.in[12] + l * DM, scr, F.lane); continue; } r -= I_OUT;
        if (r < I_G) { const int nb = FF / 32, kb = r / nb, n0 = (r % nb) * 32; transpose_item(AR.in[14] + (size_t)l * DM * FF, DM, FF, kb * 64, n0, (bf16*)((unsigned char*)wl + W_GU), 256 * (n0 / 128) + (n0 % 128), AR.in[3] + l * DM, scr, F.lane); continue; } r -= I_G;
        if (r < I_G) { const int nb = FF / 32, kb = r / nb, n0 = (r % nb) * 32; transpose_item(AR.in[15] + (size_t)l * DM * FF, DM, FF, kb * 64, n0, (bf16*)((unsigned char*)wl + W_GU), 256 * (n0 / 128) + 128 + (n0 % 128), AR.in[3] + l * DM, scr, F.lane); continue; } r -= I_G;
        { const int nb = DM / 32, kb = r / nb, n0 = (r % nb) * 32; transpose_item(AR.in[16] + (size_t)l * FF * DM, FF, DM, kb * 64, n0, (bf16*)((unsigned char*)wl + W_DN), n0, nullptr, scr, F.lane); }
    }
    const int gt = F.bid * NTHR + F.tid, GT = F.G * NTHR;
    bf16* TT = (bf16*)(F.ws + WS_TAB + TAB_TT); f32x2* TW = (f32x2*)(F.ws + WS_TAB + TAB_TW);
    for (int i = gt; i < 4096; i += GT) {
        const int n = i >> 6, c = i & 63, col = n >> 1, part = n & 1; float v;
        if (col == 0) v = part ? ((c & 1) ? -1.f : 1.f) : 1.f;
        else { const float a = (float)((col * c) & 63) * (1.0f / 32.0f); v = part ? -sinpif(a) : cospif(a); }
        TT[i] = (bf16)f2bf(v);
        const float b = (float)i * (1.0f / 4096.0f); TW[i] = (f32x2){cospif(b), -sinpif(b)};
    }
    for (int l = 0; l < DEPTH; ++l) {
        unsigned char* tl = F.ws + WS_TAB + TAB_L + (size_t)l * TAB_LSTRIDE;
        bf16* POOLT = (bf16*)(tl + TAB_POOLT); bf16* FWT = (bf16*)(tl + TAB_FWT); bf16* SPW = (bf16*)(tl + TAB_SPW);
        const float* pw = AR.in[7] + (size_t)l * 4 * 64 * 64; const float* ps = AR.in[8] + l * 256; const float* fw = AR.in[9] + (size_t)l * 4 * 64 * 64; const float* sw = AR.in[10] + (size_t)l * 4 * 128 * 128;
        for (int i = gt; i < 16384; i += GT) { const int g = i >> 12, dd = (i >> 6) & 63, c = i & 63;
            POOLT[i] = (bf16)f2bf(pw[(g * 64 + c) * 64 + dd] * ps[g * 64 + dd]);
            FWT[i] = (bf16)f2bf(fw[(g * 64 + c) * 64 + dd] * 0.001381067932f); }
        for (int i = gt; i < 65536; i += GT) SPW[i] = (bf16)f2bf(sw[i]);
    }
    bf16* HB = (bf16*)(F.ws + WS_HB);
    float* RS = (float*)(F.ws + WS_RS);
    for (int m0 = gw * 4; m0 < MTOK; m0 += NGW * 4) {
        f32x4 v[4][4];
#pragma unroll
        for (int r = 0; r < 4; ++r)
#pragma unroll
            for (int j = 0; j < 4; ++j) v[r][j] = ((const f32x4*)(AR.in[0] + (size_t)(m0 + r) * DM))[F.lane + 64 * j];
#pragma unroll
        for (int r = 0; r < 4; ++r) { float s = 0.f;
#pragma unroll
            for (int j = 0; j < 4; ++j) s += (v[r][j].x * v[r][j].x + v[r][j].y * v[r][j].y) + (v[r][j].z * v[r][j].z + v[r][j].w * v[r][j].w);
            const float rs = rsqrtf(wave_sum(s) * (1.f / DM) + EPS); if (F.lane == 0) RS[m0 + r] = rs;
            u32x2* o8 = (u32x2*)(HB + (size_t)(m0 + r) * DM) + F.lane;
#pragma unroll
            for (int j = 0; j < 4; ++j) { u32x2 w; w.x = pk2(v[r][j].x, v[r][j].y); w.y = pk2(v[r][j].z, v[r][j].w); o8[64 * j] = w; } }
    }
}

__device__ __forceinline__ void conv8(const bf16* pr, int ch, bool hasL, bool hasR, const float* convw, float (&y)[8]) {
    const u32x4 zero4 = (u32x4){0u, 0u, 0u, 0u};
    float b8[8], c0[8], z0[8], cl[8], zl[8], cr[8], zr[8];
    unpack8(*(const u32x4*)(pr + ch), b8); unpack8(*(const u32x4*)(pr + 256 + ch), c0); unpack8(*(const u32x4*)(pr + 512 + ch), z0);
    unpack8(hasL ? *(const u32x4*)(pr - PROJ + 256 + ch) : zero4, cl); unpack8(hasL ? *(const u32x4*)(pr - PROJ + 512 + ch) : zero4, zl);
    unpack8(hasR ? *(const u32x4*)(pr + PROJ + 256 + ch) : zero4, cr); unpack8(hasR ? *(const u32x4*)(pr + PROJ + 512 + ch) : zero4, zr);
    const f32x4 wa0 = *(const f32x4*)(convw + ch), wa1 = *(const f32x4*)(convw + ch + 4), wb0 = *(const f32x4*)(convw + 256 + ch), wb1 = *(const f32x4*)(convw + 256 + ch + 4), wc0 = *(const f32x4*)(convw + 512 + ch), wc1 = *(const f32x4*)(convw + 512 + ch + 4);
#pragma unroll
    for (int e = 0; e < 8; ++e) { const float w0 = e < 4 ? wa0[e & 3] : wa1[e & 3], w1 = e < 4 ? wb0[e & 3] : wb1[e & 3], w2 = e < 4 ? wc0[e & 3] : wc1[e & 3];
        y[e] = b8[e] * (w0 * (cl[e] * zl[e]) + w1 * (c0[e] * z0[e]) + w2 * (cr[e] * zr[e])); }
}
constexpr int VROW = 272;
constexpr int PTROW = 528;
__device__ __forceinline__ void p_mix_gmlp(Ctx& F, const Args& AR, int l) {
    const bf16* proj = (const bf16*)(F.ws + WS_PROJ); bf16* Y = (bf16*)(F.ws + WS_Y);
    const bf16* SPW = (const bf16*)(F.ws + WS_TAB + TAB_L + (size_t)l * TAB_LSTRIDE + TAB_SPW); const float* spb = AR.in[11] + l * 4 * 128;
    const int tid = F.tid, lane = F.lane, fr = lane & 15, fq = lane >> 4, p0 = F.wave * 16;
    const int lq = tid & 127, lh = tid >> 7;
    u32x4 vpre[8];
    if (F.bid < MTOK / 128) {
#pragma unroll
        for (int i = 0; i < 8; ++i) vpre[i] = *(const u32x4*)(proj + (size_t)(F.bid * 128 + lq) * PROJ + 1536 + lh * 64 + 8 * i); }
    for (int chunk = F.bid; chunk < MTOK / 128; chunk += F.G) {
        const int R0 = chunk * 128;
        { const int q = lq, h = lh;
          float v[64]; float s = 0.f;
#pragma unroll
          for (int i = 0; i < 8; ++i) { const u32x4 w = vpre[i]; float f[8]; unpack8(w, f);
#pragma unroll
              for (int e = 0; e < 8; ++e) { v[8 * i + e] = f[e]; s += f[e]; } }
          const float mu = s * (1.f / 64.f); float s2 = 0.f;
#pragma unroll
          for (int c = 0; c < 64; ++c) { v[c] -= mu; s2 += v[c] * v[c]; }
          const float rstd = rsqrtf(s2 * (1.f / 64.f) + EPS);
#pragma unroll
          for (int c = 0; c < 64; c += 2) { const unsigned w = pk2(v[c] * rstd, v[c + 1] * rstd);
              *(LAS unsigned short*)(F.lds + (h * 64 + c) * VROW + q * 2) = (unsigned short)w; *(LAS unsigned short*)(F.lds + (h * 64 + c + 1) * VROW + q * 2) = (unsigned short)(w >> 16); }
        }
        __syncthreads();
        const size_t row = (size_t)R0 + p0 + fr; const bf16* pr = proj + row * PROJ; bf16* yr = Y + row * DM;
        { f32x4 acc[16];
#pragma unroll
          for (int i = 0; i < 16; ++i) acc[i] = (f32x4){0.f, 0.f, 0.f, 0.f};
          u32x2 uw[16]; float bias[4];
#pragma unroll
          for (int ct = 0; ct < 16; ++ct) uw[ct] = *(const u32x2*)(pr + 1280 + ct * 16 + 4 * fq);
          if (chunk + F.G < MTOK / 128) {
#pragma unroll
              for (int i = 0; i < 8; ++i) vpre[i] = *(const u32x4*)(proj + (size_t)((chunk + F.G) * 128 + lq) * PROJ + 1536 + lh * 64 + 8 * i); }
#pragma unroll
          for (int h = 0; h < 4; ++h) bias[h] = spb[h * 128 + p0 + fr];
#pragma unroll
          for (int h = 0; h < 4; ++h)
#pragma unroll
              for (int ks = 0; ks < 4; ++ks) { const bf16x8 wf = *(const bf16x8*)(SPW + ((size_t)(h * 128 + p0 + fr) * 128 + ks * 32 + 8 * fq));
#pragma unroll
                  for (int nt = 0; nt < 4; ++nt) { const int ct = h * 4 + nt; const bf16x8 vf = *(const LAS bf16x8*)(F.lds + (ct * 16 + fr) * VROW + (ks * 32 + 8 * fq) * 2);
                      acc[ct] = MFMA16(vf, wf, acc[ct]); } }
          float ssq = 0.f;
#pragma unroll
          for (int ct = 0; ct < 16; ++ct) { const float bs = bias[ct >> 2];
              f32x4 y; y[0] = bf_lo(uw[ct].x) * (acc[ct][0] + bs); y[1] = bf_hi(uw[ct].x) * (acc[ct][1] + bs); y[2] = bf_lo(uw[ct].y) * (acc[ct][2] + bs); y[3] = bf_hi(uw[ct].y) * (acc[ct][3] + bs);
              acc[ct] = y; ssq += (y[0] * y[0] + y[1] * y[1]) + (y[2] * y[2] + y[3] * y[3]); }
          ssq += __shfl_xor(ssq, 16); ssq += __shfl_xor(ssq, 32);
          const float rs = rsqrtf(ssq * (1.f / 256.f) + EPS);
#pragma unroll
          for (int ct = 0; ct < 16; ++ct) { u32x2 w; w.x = pk2(acc[ct][0] * rs, acc[ct][1] * rs); w.y = pk2(acc[ct][2] * rs, acc[ct][3] * rs); *(u32x2*)(yr + 768 + ct * 16 + 4 * fq) = w; }
        }
        __syncthreads();
    }
}
__device__ __forceinline__ void p_mix_pool(Ctx& F, int l) {
    const bf16* proj = (const bf16*)(F.ws + WS_PROJ); bf16* Y = (bf16*)(F.ws + WS_Y);
    const bf16* POOLT = (const bf16*)(F.ws + WS_TAB + TAB_L + (size_t)l * TAB_LSTRIDE + TAB_POOLT);
    const int lane = F.lane, fr = lane & 15, fq = lane >> 4;
    LAS unsigned char* reg = F.lds + F.wave * (32 * PTROW);
    const int gw = F.bid * NWAVES + F.wave, NGW = F.G * NWAVES;
    const u32x4 zero4 = (u32x4){0u, 0u, 0u, 0u};
    for (int item = gw; item < MTOK / 16; item += NGW) {
        const int m0 = item * 16, tp0 = m0 % SEQ;
        { u32x4 pv[16];
#pragma unroll
          for (int i = 0; i < 16; ++i) { const int r = 2 * i + (lane >> 5), pc = lane & 31, tt = tp0 + r - 8; const int gr = min(max(m0 + r - 8, 0), MTOK - 1);
              const u32x4 raw = *(const u32x4*)(proj + (size_t)gr * PROJ + 768 + pc * 8); pv[i] = (tt >= 0 && tt < SEQ) ? raw : zero4; }
#pragma unroll
          for (int i = 0; i < 16; ++i) { const int r = 2 * i + (lane >> 5), pc = lane & 31; *(LAS u32x4*)(reg + r * PTROW + pc * 16) = pv[i]; }
        }
        asm volatile("s_waitcnt lgkmcnt(0)" ::: "memory");
        const int t = tp0 + fr; bf16* yr = Y + (size_t)(m0 + fr) * DM;
        f32x4 acc[16];
#pragma unroll
        for (int i = 0; i < 16; ++i) acc[i] = (f32x4){0.f, 0.f, 0.f, 0.f};
        const LAS unsigned char* ptl = reg + fr * PTROW;
#pragma unroll
        for (int g = 0; g < 4; ++g) { const int half = 1 << g; const int lo = max(t - half, 0), hi = min(t + half, SEQ); const float inv = 1.0f / (float)(hi - lo);
#pragma unroll
            for (int ks = 0; ks < 2; ++ks) { const int chb = (g * 64 + ks * 32 + 8 * fq) * 2; float s[8];
#pragma unroll
                for (int e = 0; e < 8; ++e) s[e] = 0.f;
#pragma unroll
                for (int i = 0; i < 2 * half; ++i) { float f[8]; unpack8(*(const LAS u32x4*)(ptl + (8 + i - half) * PTROW + chb), f);
#pragma unroll
                    for (int e = 0; e < 8; ++e) s[e] += f[e]; }
                float sf[8]; unpack8(*(const LAS u32x4*)(ptl + 8 * PTROW + chb), sf);
#pragma unroll
                for (int e = 0; e < 8; ++e) s[e] = s[e] * inv - sf[e];
                const bf16x8 df = __builtin_bit_cast(bf16x8, pack8(s));
#pragma unroll
                for (int nt = 0; nt < 4; ++nt) { const bf16x8 pf = *(const bf16x8*)(POOLT + ((size_t)(g * 64 + nt * 16 + fr) * 64 + ks * 32 + 8 * fq));
                    acc[g * 4 + nt] = MFMA16(pf, df, acc[g * 4 + nt]); }
                asm volatile("" ::: "memory"); } }
        float ssq = 0.f;
#pragma unroll
        for (int ct = 0; ct < 16; ++ct) ssq += (acc[ct][0] * acc[ct][0] + acc[ct][1] * acc[ct][1]) + (acc[ct][2] * acc[ct][2] + acc[ct][3] * acc[ct][3]);
        ssq += __shfl_xor(ssq, 16); ssq += __shfl_xor(ssq, 32);
        const float rs = rsqrtf(ssq * (1.f / 256.f) + EPS);
#pragma unroll
        for (int ct = 0; ct < 16; ++ct) { u32x2 w; w.x = pk2(acc[ct][0] * rs, acc[ct][1] * rs); w.y = pk2(acc[ct][2] * rs, acc[ct][3] * rs); *(u32x2*)(yr + 256 + ct * 16 + 4 * fq) = w; }
        asm volatile("s_waitcnt lgkmcnt(0)" ::: "memory");
    }
}
__device__ __forceinline__ void p_mix_conv(Ctx& F, const Args& AR, int l) {
    const bf16* proj = (const bf16*)(F.ws + WS_PROJ); bf16* Y = (bf16*)(F.ws + WS_Y);
    const float* convw = AR.in[6] + l * 3 * 256;
    const int lane = F.lane, l32 = lane & 31, hw = lane >> 5, cch = 8 * l32;
    const int gw = F.bid * NWAVES + F.wave, NGW = F.G * NWAVES;
    const u32x4 zero4 = (u32x4){0u, 0u, 0u, 0u};
    float w0[8], w1[8], w2[8];
#pragma unroll
    for (int e = 0; e < 8; ++e) { w0[e] = convw[cch + e]; w1[e] = convw[256 + cch + e]; w2[e] = convw[512 + cch + e]; }
    for (int item = gw; item < MTOK / 16; item += NGW) {
        const int mb = item * 16 + 8 * hw, tq = mb % SEQ;
        const bf16* pc = proj + (size_t)mb * PROJ + cch; bf16* yc = Y + (size_t)mb * DM + cch;
        u32x4 bw[8], cv[10], zv[10];
#pragma unroll
        for (int i = 0; i < 8; ++i) bw[i] = *(const u32x4*)(pc + (size_t)i * PROJ);
#pragma unroll
        for (int i = 0; i < 10; ++i) { const int tt = tq + i - 1; const bool ok = tt >= 0 && tt < SEQ; const int gr = min(max(mb + i - 1, 0), MTOK - 1); const bf16* pq = proj + (size_t)gr * PROJ + cch;
            const u32x4 rc = *(const u32x4*)(pq + 256), rz = *(const u32x4*)(pq + 512); cv[i] = ok ? rc : zero4; zv[i] = ok ? rz : zero4; }
        float czp[8], czc[8], czn[8];
        { float a[8], b[8]; unpack8(cv[0], a); unpack8(zv[0], b);
#pragma unroll
          for (int e = 0; e < 8; ++e) czp[e] = a[e] * b[e];
          unpack8(cv[1], a); unpack8(zv[1], b);
#pragma unroll
          for (int e = 0; e < 8; ++e) czc[e] = a[e] * b[e]; }
#pragma unroll
        for (int i = 0; i < 8; ++i) { float a[8], b[8], y[8]; unpack8(cv[i + 2], a); unpack8(zv[i + 2], b);
#pragma unroll
            for (int e = 0; e < 8; ++e) czn[e] = a[e] * b[e];
            unpack8(bw[i], b); float ssq = 0.f;
#pragma unroll
            for (int e = 0; e < 8; ++e) { y[e] = b[e] * (w0[e] * czp[e] + w1[e] * czc[e] + w2[e] * czn[e]); ssq += y[e] * y[e]; }
            ssq += __shfl_xor(ssq, 1); ssq += __shfl_xor(ssq, 2); ssq += __shfl_xor(ssq, 4); ssq += __shfl_xor(ssq, 8); ssq += __shfl_xor(ssq, 16);
            const float rs = rsqrtf(ssq * (1.f / 256.f) + EPS);
#pragma unroll
            for (int e = 0; e < 8; ++e) { y[e] *= rs; czp[e] = czc[e]; czc[e] = czn[e]; }
            *(u32x4*)(yc + (size_t)i * DM) = pack8(y); }
    }
}
__device__ __forceinline__ void p_mix_f1(Ctx& F) {
    const bf16* proj = (const bf16*)(F.ws + WS_PROJ); f32x2* H = (f32x2*)(F.ws + WS_H); const bf16* TT = (const bf16*)(F.ws + WS_TAB + TAB_TT);
    const int lane = F.lane, fr = lane & 15, fq = lane >> 4;
    const int gw = F.bid * NWAVES + F.wave, NGW = F.G * NWAVES;
    bf16x8 tf[2][4];
#pragma unroll
    for (int ks = 0; ks < 2; ++ks)
#pragma unroll
        for (int nt = 0; nt < 4; ++nt) tf[ks][nt] = *(const bf16x8*)(TT + (nt * 16 + fr) * 64 + ks * 32 + 8 * fq);
    for (int item = gw; item < MTOK / 16; item += 2 * NGW) {
        bf16x8 ff[2][4][2];
#pragma unroll
        for (int it = 0; it < 2; ++it) { const int m = min(item + it * NGW, MTOK / 16 - 1) * 16 + fr; const bf16* pr = proj + (size_t)m * PROJ + 1024;
#pragma unroll
            for (int h = 0; h < 4; ++h)
#pragma unroll
                for (int ks = 0; ks < 2; ++ks) ff[it][h][ks] = *(const bf16x8*)(pr + h * 64 + ks * 32 + 8 * fq); }
#pragma unroll
        for (int it = 0; it < 2; ++it) { if (item + it * NGW >= MTOK / 16) break; const int m = (item + it * NGW) * 16 + fr, bb = m / SEQ, t = m % SEQ;
#pragma unroll
            for (int h = 0; h < 4; ++h) { f32x4 a4[4];
#pragma unroll
                for (int i = 0; i < 4; ++i) a4[i] = (f32x4){0.f, 0.f, 0.f, 0.f};
#pragma unroll
                for (int ks = 0; ks < 2; ++ks)
#pragma unroll
                    for (int nt = 0; nt < 4; ++nt) a4[nt] = MFMA16(tf[ks][nt], ff[it][h][ks], a4[nt]);
#pragma unroll
                for (int nt = 0; nt < 4; ++nt) { f32x2* hp = H + ((size_t)((bb * 4 + h) * 32 + 8 * nt + 2 * fq) * SEQ + t);
                    hp[0] = (f32x2){a4[nt][0], a4[nt][1]}; hp[SEQ] = (f32x2){a4[nt][2], a4[nt][3]}; } } }
    }
}

__device__ __forceinline__ f32x2 cmul(const f32x2 a, const f32x2 b) { return (f32x2){a.x * b.x - a.y * b.y, a.x * b.y + a.y * b.x}; }
__device__ __forceinline__ void dft4(f32x2& a0, f32x2& a1, f32x2& a2, f32x2& a3) {
    const f32x2 s02 = a0 + a2, d02 = a0 - a2, s13 = a1 + a3, d13 = a1 - a3; const f32x2 md = (f32x2){d13.y, -d13.x};
    a0 = s02 + s13; a1 = d02 + md; a2 = s02 - s13; a3 = d02 - md;
}
__device__ __forceinline__ void dft16(f32x2 (&u)[16]) {
#pragma unroll
    for (int q2 = 0; q2 < 4; ++q2) dft4(u[q2], u[4 + q2], u[8 + q2], u[12 + q2]);
    const float c1 = 0.92387953251128674f, s1 = 0.38268343236508977f, r = 0.70710678118654752f;
    const f32x2 W1 = (f32x2){c1, -s1}, W2 = (f32x2){r, -r}, W3 = (f32x2){s1, -c1}, W4 = (f32x2){0.f, -1.f}, W6 = (f32x2){-r, -r}, W9 = (f32x2){-c1, s1};
    u[5] = cmul(u[5], W1); u[6] = cmul(u[6], W2); u[7] = cmul(u[7], W3);
    u[9] = cmul(u[9], W2); u[10] = cmul(u[10], W4); u[11] = cmul(u[11], W6);
    u[13] = cmul(u[13], W3); u[14] = cmul(u[14], W6); u[15] = cmul(u[15], W9);
#pragma unroll
    for (int n1 = 0; n1 < 4; ++n1) dft4(u[4 * n1], u[4 * n1 + 1], u[4 * n1 + 2], u[4 * n1 + 3]);
}
__device__ __forceinline__ int PX(int i) { return i + (i >> 4); }
__device__ __forceinline__ void p_fft(Ctx& F) {
    LAS f32x2* X = (LAS f32x2*)F.lds; LAS f32x2* TWL = (LAS f32x2*)(F.lds + 69632);
    const f32x2* TW = (const f32x2*)(F.ws + WS_TAB + TAB_TW); const f32x2* H = (const f32x2*)(F.ws + WS_H); float* A = (float*)(F.ws + WS_A);
    const int tid = F.tid;
    for (int i = tid; i < 4096; i += NTHR) TWL[i] = TW[i];
    f32x2 pre[16];
    if (F.bid < BATCH * 4 * 32) {
#pragma unroll
        for (int q = 0; q < 16; ++q) pre[q] = H[(size_t)F.bid * SEQ + tid + NTHR * q]; }
    for (int colid = F.bid; colid < BATCH * 4 * 32; colid += F.G) {
        f32x2 u[16];
#pragma unroll
        for (int q = 0; q < 16; ++q) u[q] = pre[q];
        if (colid + F.G < BATCH * 4 * 32) {
#pragma unroll
            for (int q = 0; q < 16; ++q) pre[q] = H[(size_t)(colid + F.G) * SEQ + tid + NTHR * q]; }
        dft16(u);
        __syncthreads();
#pragma unroll
        for (int ri = 0; ri < 16; ++ri) X[PX(16 * tid + (ri >> 2) + 4 * (ri & 3))] = u[ri];
        __syncthreads();
#pragma unroll
        for (int ps = 0; ps < 2; ++ps) { const int Ns = ps ? 256 : 16, k = tid & (Ns - 1); const f32x2 w = TWL[ps ? 2 * k : 32 * k];
#pragma unroll
            for (int q = 0; q < 16; ++q) u[q] = X[PX(tid + NTHR * q)];
            f32x2 wq = w; u[1] = cmul(u[1], wq);
#pragma unroll
            for (int q = 2; q < 16; ++q) { wq = cmul(wq, w); u[q] = cmul(u[q], wq); }
            dft16(u);
            __syncthreads();
            const int j0 = ((tid - k) << 4) + k;
#pragma unroll
            for (int ri = 0; ri < 16; ++ri) X[PX(j0 + ((ri >> 2) + 4 * (ri & 3)) * Ns)] = u[ri];
            __syncthreads(); }
        const int bh = colid >> 5, col = colid & 31;
        if (col != 0) { float* dst = A + ((size_t)bh * 33 + col) * SEQ;
#pragma unroll
            for (int i = 0; i < 8; ++i) { const int j = tid + NTHR * i; const f32x2 a = X[PX(j)], b = cmul(X[PX(j + 4096)], TWL[j]); dst[j] = a.x + b.x; dst[j + 4096] = a.x - b.x; } }
        else {
            f32x2 z0[8], z1[8];
#pragma unroll
            for (int i = 0; i < 8; ++i) { const int j = tid + NTHR * i; const f32x2 a = X[PX(j)], b = cmul(X[PX(j + 4096)], TWL[j]); z0[i] = a + b; z1[i] = a - b; }
            __syncthreads();
#pragma unroll
            for (int i = 0; i < 8; ++i) { const int j = tid + NTHR * i; X[PX(j)] = z0[i]; X[PX(j + 4096)] = z1[i]; }
            __syncthreads();
            float* d0 = A + ((size_t)bh * 33) * SEQ; float* d32 = A + ((size_t)bh * 33 + 32) * SEQ;
#pragma unroll
            for (int i = 0; i < 16; ++i) { const int k = tid + NTHR * i, km = (SEQ - k) & (SEQ - 1); const f32x2 a = X[PX(k)], b = X[PX(km)]; d0[k] = 0.5f * (a.x + b.x); d32[k] = 0.5f * (a.y + b.y); } }
    }
}

__device__ __forceinline__ void p_fourier_out(Ctx& F, int l) {
    const float* A = (const float*)(F.ws + WS_A); bf16* Y = (bf16*)(F.ws + WS_Y);
    const bf16* FWT = (const bf16*)(F.ws + WS_TAB + TAB_L + (size_t)l * TAB_LSTRIDE + TAB_FWT);
    const int lane = F.lane, fr = lane & 15, fq = lane >> 4;
    const int gw = F.bid * NWAVES + F.wave, NGW = F.G * NWAVES;
    for (int item = gw; item < MTOK / 16; item += NGW) {
        const int m0 = item * 16, bb = m0 / SEQ, k = (m0 % SEQ) + fr, km = (SEQ - k) & (SEQ - 1);
        f32x4 acc[16];
#pragma unroll
        for (int i = 0; i < 16; ++i) acc[i] = (f32x4){0.f, 0.f, 0.f, 0.f};
#pragma unroll
        for (int h = 0; h < 4; ++h) { const float* Ab = A + (size_t)(bb * 4 + h) * 33 * SEQ;
#pragma unroll
            for (int ks = 0; ks < 2; ++ks) { float s[8];
#pragma unroll
                for (int e = 0; e < 8; ++e) { const int jp = ks * 32 + 8 * fq + e; s[e] = (jp <= 32) ? Ab[(size_t)jp * SEQ + k] : Ab[(size_t)(64 - jp) * SEQ + km]; }
                const bf16x8 sf = __builtin_bit_cast(bf16x8, pack8(s));
#pragma unroll
                for (int nt = 0; nt < 4; ++nt) { const bf16x8 wf = *(const bf16x8*)(FWT + ((size_t)(h * 64 + nt * 16 + fr) * 64 + ks * 32 + 8 * fq));
                    acc[h * 4 + nt] = MFMA16(wf, sf, acc[h * 4 + nt]); } } }
        float ssq = 0.f;
#pragma unroll
        for (int ct = 0; ct < 16; ++ct) ssq += (acc[ct][0] * acc[ct][0] + acc[ct][1] * acc[ct][1]) + (acc[ct][2] * acc[ct][2] + acc[ct][3] * acc[ct][3]);
        ssq += __shfl_xor(ssq, 16); ssq += __shfl_xor(ssq, 32);
        const float rs = rsqrtf(ssq * (1.f / 256.f) + EPS);
        bf16* yr = Y + (size_t)(m0 + fr) * DM + 512;
#pragma unroll
        for (int ct = 0; ct < 16; ++ct) { u32x2 w; w.x = pk2(acc[ct][0] * rs, acc[ct][1] * rs); w.y = pk2(acc[ct][2] * rs, acc[ct][3] * rs); *(u32x2*)(yr + ct * 16 + 4 * fq) = w; }
    }
}

__device__ __forceinline__ void p_residual(Ctx& F, float* xout, const float* gain, bool last) {
    const bf16* MB = (const bf16*)(F.ws + WS_MB); const float* SS = (const float*)(F.ws + WS_SS); bf16* XB = (bf16*)(F.ws + WS_HB); float* RS = (float*)(F.ws + WS_RS);
    const int lane = F.lane, gw = F.bid * NWAVES + F.wave, NGW = F.G * NWAVES;
    constexpr int ER = 4;
    f32x4 g[2][2];
#pragma unroll
    for (int j = 0; j < 2; ++j) { g[j][0] = *(const f32x4*)(gain + 8 * lane + 512 * j); g[j][1] = *(const f32x4*)(gain + 8 * lane + 512 * j + 4); }
    for (int m0 = gw * ER; m0 < MTOK; m0 += NGW * ER) {
        u32x4 mw[ER][2], xw[ER][2]; float sp[ER];
#pragma unroll
        for (int r = 0; r < ER; ++r) { const size_t m = (size_t)m0 + r; sp[r] = SS[m * 16 + (lane & 15)];
#pragma unroll
            for (int j = 0; j < 2; ++j) { mw[r][j] = *(const u32x4*)(MB + m * DM + 8 * lane + 512 * j); xw[r][j] = *(const u32x4*)(XB + m * DM + 8 * lane + 512 * j); } }
#pragma unroll
        for (int r = 0; r < ER; ++r) { const size_t m = (size_t)m0 + r; float q = sp[r];
            q += __shfl_xor(q, 1); q += __shfl_xor(q, 2); q += __shfl_xor(q, 4); q += __shfl_xor(q, 8);
            const float rsm = rsqrtf(q * (1.f / DM) + EPS);
            float v[2][8]; float s = 0.f;
#pragma unroll
            for (int j = 0; j < 2; ++j) { float mf[8], xf[8]; unpack8(mw[r][j], mf); unpack8(xw[r][j], xf);
#pragma unroll
                for (int e = 0; e < 8; ++e) { const float gg = e < 4 ? g[j][0][e & 3] : g[j][1][e & 3]; v[j][e] = xf[e] + mf[e] * rsm * gg; s += v[j][e] * v[j][e]; } }
            if (!last) { const float rs = rsqrtf(wave_sum(s) * (1.f / DM) + EPS); if (lane == 0) RS[m] = rs;
#pragma unroll
                for (int j = 0; j < 2; ++j) *(u32x4*)(XB + m * DM + 8 * lane + 512 * j) = pack8(v[j]); }
            else {
#pragma unroll
                for (int j = 0; j < 2; ++j) { f32x4* xo = (f32x4*)(xout + m * DM + 8 * lane + 512 * j); xo[0] = (f32x4){v[j][0], v[j][1], v[j][2], v[j][3]}; xo[1] = (f32x4){v[j][4], v[j][5], v[j][6], v[j][7]}; } }
        }
    }
}

#define RLX_AGENT __ATOMIC_RELAXED, __HIP_MEMORY_SCOPE_AGENT
#define XB_TMO      128
#define XB_XCNT(j)  (256  + 64 * (j))
#define XB_XSUB(j)  (1280 + 64 * (j))
#define XB_XGEN(j)  (2304 + 64 * (j))
#define XB_TOP      3328
#define XB_TOPGEN   3392
#define XCD_BAR_WORDS 3456
#define XB_SPIN_CAP (1u << 18)

__device__ __forceinline__ unsigned xb_ld(unsigned* p)              { return __hip_atomic_load(p, __ATOMIC_RELAXED, __HIP_MEMORY_SCOPE_AGENT); }
__device__ __forceinline__ unsigned xb_add(unsigned* p, unsigned v) { return __hip_atomic_fetch_add(p, v, __ATOMIC_RELAXED, __HIP_MEMORY_SCOPE_AGENT); }
__device__ __forceinline__ unsigned xb_xcc_id() { return (unsigned)__builtin_amdgcn_s_getreg((3 << 11) | 20) & 0xFu; }
#define XB_SPIN(cond, bar) do { unsigned _sp = 0; while (cond) { __builtin_amdgcn_s_sleep(1); \
    if ((++_sp & 255u) == 0u) { if (xb_ld(&(bar)[XB_TMO])) break; if (_sp > XB_SPIN_CAP) { atomicAdd(&(bar)[XB_TMO], 1u); break; } } } } while (0)

struct XcdBarrier {
    unsigned* bar; unsigned x;
    volatile LAS unsigned* st;
};

__device__ __forceinline__ XcdBarrier xcd_barrier_post(unsigned* bar, volatile LAS unsigned* st) {
    XcdBarrier b; b.bar = bar; b.x = xb_xcc_id(); b.st = st;
    if (threadIdx.x == 0) (void)xb_add(&bar[XB_XCNT(b.x)], 1u);
    return b;
}
__device__ __forceinline__ void xcd_barrier_complete(unsigned* bar, unsigned x, unsigned& nloc, unsigned& nx) {
    const unsigned G = gridDim.x * gridDim.y * gridDim.z;
    unsigned sum, cnt, mine, sp = 0u;
    for (;;) {
        sum = 0u; cnt = 0u; mine = 0u;
#pragma unroll
        for (unsigned j = 0; j < 16; ++j) { const unsigned c = xb_ld(&bar[XB_XCNT(j)]); sum += c; cnt += (c > 0u) ? 1u : 0u; mine = (j == x) ? c : mine; }
        if (sum == G) break;
        __builtin_amdgcn_s_sleep(1);
        if ((++sp & 255u) == 0u) { if (xb_ld(&bar[XB_TMO])) break; if (sp > XB_SPIN_CAP) { atomicAdd(&bar[XB_TMO], 1u); break; } }
    }
    nloc = mine > 0u ? mine : 1u; nx = cnt > 0u ? cnt : 1u;
}

__device__ __forceinline__ void xcd_barrier(const XcdBarrier& b) {
    asm volatile("s_waitcnt vmcnt(0)" ::: "memory");
    __syncthreads();
    if (threadIdx.x == 0) {
        unsigned* bar = b.bar;
        __builtin_amdgcn_s_waitcnt(0);
        unsigned nloc = b.st[0], nx = b.st[1];
        if (nloc == 0u) { xcd_barrier_complete(bar, b.x, nloc, nx); b.st[0] = nloc; b.st[1] = nx; }
        const unsigned old = xb_add(&bar[XB_XSUB(b.x)], 1u);
        const unsigned gen = old / nloc;
        if (old + 1u == (gen + 1u) * nloc) {
            __builtin_amdgcn_fence(__ATOMIC_RELEASE, "agent");
            asm volatile("s_waitcnt vmcnt(0)" ::: "memory");
            const unsigned og = xb_add(&bar[XB_TOP], 1u);
            const unsigned tg = og / nx;
            if (og + 1u == (tg + 1u) * nx) xb_add(&bar[XB_TOPGEN], 1u);
            else XB_SPIN(xb_ld(&bar[XB_TOPGEN]) == tg, bar);
            __builtin_amdgcn_fence(__ATOMIC_ACQUIRE, "agent");
            xb_add(&bar[XB_XGEN(b.x)], 1u);
            asm volatile("s_waitcnt vmcnt(0)" ::: "memory");
        } else {
            XB_SPIN(xb_ld(&bar[XB_XGEN(b.x)]) == gen, bar);
            __builtin_amdgcn_fence(__ATOMIC_ACQUIRE, "agent");
            asm volatile("s_waitcnt vmcnt(0)" ::: "memory");
        }
    }
    __syncthreads();
}

__global__ void __launch_bounds__(NTHR, 2) mk_fwd(Args args) {
    extern __shared__ __attribute__((aligned(16))) unsigned char lds_raw[];
#define MKCTX() Ctx F; { int t_ = threadIdx.x; asm volatile("" : "+v"(t_)); int b_ = blockIdx.x, g_ = gridDim.x; asm volatile("" : "+s"(b_), "+s"(g_)); \
        F.lds = (LAS unsigned char*)lds_raw; F.tid = t_; F.lane = t_ & 63; F.wave = __builtin_amdgcn_readfirstlane(t_ >> 6); F.G = g_; F.bid = b_; F.ws = args.ws; }
    const int lo = args.ph_lo, hi = args.ph_hi;
#define IN(k) (lo <= (k) && (k) < hi)
#ifndef PH_MASK
#define PH_MASK 0x3ff
#endif
#define EN(b) ((PH_MASK >> (b)) & 1)
#ifndef REP_MASK
#define REP_MASK 0
#endif
#define REPS(b) (1 + ((REP_MASK >> (b)) & 1))
#define SEAM(k) do { if (IN(k) && IN((k) + 1)) xcd_barrier(bar); } while (0)
#define WSP(T, off) ((T*)(args.ws + (off)))
    unsigned* const barw = (unsigned*)(args.ws + WS_CTL);
    volatile LAS unsigned* const bst = (volatile LAS unsigned*)((LAS unsigned char*)lds_raw + 149552);
    if (threadIdx.x < 2) bst[threadIdx.x] = 0u;
    if (IN(0) && blockIdx.x == 0) for (int i = threadIdx.x; i < CW_WORDS; i += NTHR) __hip_atomic_store(barw + i, 0u, RLX_AGENT);
    if (IN(0) && EN(9)) for (int rep_ = 0; rep_ < REPS(9); ++rep_) { MKCTX(); p_prologue(F, args); }
    XcdBarrier bar; bar.bar = barw; bar.x = 0; bar.st = bst;
    if (IN(0) && IN(1)) { cg::this_grid().sync(); bar = xcd_barrier_post(barw, bst); }
#pragma unroll 1
    for (int l = 0; l < DEPTH; ++l) {
        const int pb = 1 + 9 * l;
        if (IN(pb + 0) && EN(0)) for (int rep_ = 0; rep_ < REPS(0); ++rep_) { MKCTX(); pg8::Gemm g{WSP(const bf16, WS_HB), WSP(const bf16, WS_W + (size_t)l * W_LSTRIDE + W_IN), MTOK, PROJ, DM}; pg8::StaticOrder S; S.init(MTOK, PROJ, F.G, F.bid); pg8::EpiPlain E{WSP(bf16, WS_PROJ), PROJ, WSP(const float, WS_RS), F.lds + 131072};
            pg8::gemm_phase<pg8::EpiPlain, pg8::StaticOrder, true, true>(F.lds, g, S, E); }
        SEAM(pb + 0);
        if (IN(pb + 1) && EN(1)) for (int rep_ = 0; rep_ < REPS(1); ++rep_) {
            for (int r_ = 0; r_ < 1 + (M1_REP & 1); ++r_) { MKCTX(); p_mix_conv(F, args, l); }
            for (int r_ = 0; r_ < 1 + ((M1_REP >> 1) & 1); ++r_) { MKCTX(); p_mix_f1(F); }
            for (int r_ = 0; r_ < 1 + ((M1_REP >> 2) & 1); ++r_) { MKCTX(); p_mix_pool(F, l); }
            __syncthreads();
            for (int r_ = 0; r_ < 1 + ((M1_REP >> 3) & 1); ++r_) { MKCTX(); p_mix_gmlp(F, args, l); } }
        SEAM(pb + 1);
        if (IN(pb + 2) && EN(2)) for (int rep_ = 0; rep_ < REPS(2); ++rep_) { MKCTX(); p_fft(F); }
        SEAM(pb + 2);
        if (IN(pb + 3) && EN(3)) for (int rep_ = 0; rep_ < REPS(3); ++rep_) { MKCTX(); p_fourier_out(F, l); }
        SEAM(pb + 3);
        if (IN(pb + 4) && EN(4)) for (int rep_ = 0; rep_ < REPS(4); ++rep_) { MKCTX(); pg8::Gemm g{WSP(const bf16, WS_Y), WSP(const bf16, WS_W + (size_t)l * W_LSTRIDE + W_OUT), MTOK, DM, DM}; pg8::StaticOrder S; S.init(MTOK, DM, F.G, F.bid);
#if FUSE_E
            pg8::EpiFused E{WSP(bf16, WS_HB), args.in[2] + l * DM, WSP(unsigned, WS_XS), WSP(unsigned, WS_P2), WSP(float, WS_RS), barw + CW_CNT + (4 * l + 0) * CW_CNT_SET, barw + CW_CNT + (4 * l + 1) * CW_CNT_SET, args.out, 0, F.lds + 131072};
            pg8::gemm_phase<pg8::EpiFused, pg8::StaticOrder, true, true>(F.lds, g, S, E); }
#else
            pg8::EpiSS E{WSP(bf16, WS_MB), DM, WSP(float, WS_SS)};
            pg8::gemm_phase<pg8::EpiSS, pg8::StaticOrder, true, true>(F.lds, g, S, E); }
#endif
        SEAM(pb + 4);
#if !FUSE_E
        if (IN(pb + 5) && EN(5)) for (int rep_ = 0; rep_ < REPS(5); ++rep_) { MKCTX(); p_residual(F, args.out, args.in[2] + l * DM, false); }
        SEAM(pb + 5);
#endif
        if (IN(pb + 6) && EN(6)) for (int rep_ = 0; rep_ < REPS(6); ++rep_) { MKCTX(); pg8::Gemm g{WSP(const bf16, WS_HB), WSP(const bf16, WS_W + (size_t)l * W_LSTRIDE + W_GU), MTOK, NGU, DM}; pg8::StaticOrder S; S.init(MTOK, NGU, F.G, F.bid); pg8::EpiSwiGLU E{WSP(bf16, WS_ACT), FF, WSP(const float, WS_RS), F.lds + 131072};
            pg8::gemm_phase<pg8::EpiSwiGLU, pg8::StaticOrder, true, true>(F.lds, g, S, E); }
        SEAM(pb + 6);
        if (IN(pb + 7) && EN(7)) for (int rep_ = 0; rep_ < REPS(7); ++rep_) { MKCTX(); pg8::Gemm g{WSP(const bf16, WS_ACT), WSP(const bf16, WS_W + (size_t)l * W_LSTRIDE + W_DN), MTOK, DM, FF}; pg8::StaticOrder S; S.init(MTOK, DM, F.G, F.bid);
#if FUSE_E
            pg8::EpiFused E{WSP(bf16, WS_HB), args.in[4] + l * DM, WSP(unsigned, WS_XS), WSP(unsigned, WS_P2), WSP(float, WS_RS), barw + CW_CNT + (4 * l + 2) * CW_CNT_SET, barw + CW_CNT + (4 * l + 3) * CW_CNT_SET, args.out, (l + 1 == DEPTH) ? 1 : 0, F.lds + 131072};
            pg8::gemm_phase<pg8::EpiFused, pg8::StaticOrder, true, true>(F.lds, g, S, E); }
#else
            pg8::EpiSS E{WSP(bf16, WS_MB), DM, WSP(float, WS_SS)};
            pg8::gemm_phase<pg8::EpiSS, pg8::StaticOrder, true, true>(F.lds, g, S, E); }
#endif
#if FUSE_E
        if (l + 1 < DEPTH) SEAM(pb + 7);
#else
        SEAM(pb + 7);
        if (IN(pb + 8) && EN(8)) for (int rep_ = 0; rep_ < REPS(8); ++rep_) { MKCTX(); p_residual(F, args.out, args.in[4] + l * DM, l + 1 == DEPTH); }
        SEAM(pb + 8);
#endif
    }
#undef IN
#undef SEAM
#undef WSP
}

extern "C" void kernel_launch(void* const* d_in, const int* in_sizes, int n_in, void* d_out, int out_size, void* d_ws, size_t ws_size, hipStream_t stream) {
    static int grid = 0;
    if (grid == 0) {
        if (n_in != 17 || in_sizes[0] != MTOK * DM || out_size != MTOK * DM || ws_size < WS_END) { fprintf(stderr, "kernel_launch: unexpected shapes (n_in %d, in0 %d, out %d, ws %zu)\n", n_in, n_in > 0 ? in_sizes[0] : -1, out_size, ws_size); grid = -1; return; }
        int dev = 0, cus = 0, per_cu = 0;
        if (hipGetDevice(&dev) != hipSuccess || hipDeviceGetAttribute(&cus, hipDeviceAttributeMultiprocessorCount, dev) != hipSuccess) { grid = -1; return; }
        if (hipFuncSetAttribute((const void*)mk_fwd, hipFuncAttributeMaxDynamicSharedMemorySize, LDS_BYTES) != hipSuccess) { fprintf(stderr, "kernel_launch: hipFuncSetAttribute failed\n"); grid = -1; return; }
        if (hipOccupancyMaxActiveBlocksPerMultiprocessor(&per_cu, (const void*)mk_fwd, NTHR, LDS_BYTES) != hipSuccess || per_cu < 1) { fprintf(stderr, "kernel_launch: occupancy query says %d\n", per_cu); per_cu = 1; }
        (void)hipGetLastError();
        grid = cus * 1;
        fprintf(stderr, "kernel_launch: grid %d (cus %d, per_cu %d)\n", grid, cus, per_cu);
    }
    if (grid < 0) return;
    Args a{};
    for (int i = 0; i < 17; ++i) a.in[i] = (const float*)d_in[i];
    a.out = (float*)d_out; a.ws = (unsigned char*)d_ws;
#if MK_SINGLE
    a.ph_lo = 0; a.ph_hi = NPHASE;
    void* kargs[] = {&a};
    hipError_t e = hipLaunchCooperativeKernel((const void*)mk_fwd, dim3(grid), dim3(NTHR), kargs, LDS_BYTES, stream);
    if (e != hipSuccess) fprintf(stderr, "kernel_launch: cooperative launch failed: %s (grid %d)\n", hipGetErrorString(e), grid);
#else
    for (int ph = 0; ph < NPHASE; ++ph) { a.ph_lo = ph; a.ph_hi = ph + 1; hipLaunchKernelGGL(mk_fwd, dim3(grid), dim3(NTHR), LDS_BYTES, stream, a); }
#endif
}
```

```cpp
#include <hip/hip_runtime.h>
#include <hip/hip_cooperative_groups.h>
#include <cstdio>
#include <cstdint>
namespace cg = cooperative_groups;
#ifndef DUPSTORE
#define DUPSTORE 0
#endif
namespace pg8 {
#define PG8_LAS __attribute__((address_space(3)))
typedef unsigned short bf16_t;
typedef short bf16x8 __attribute__((ext_vector_type(8)));
typedef float f32x4 __attribute__((ext_vector_type(4)));
typedef unsigned u32x4 __attribute__((ext_vector_type(4)));
constexpr int BM = 256, BK = 64, HALF = 128, HTB = HALF * BK * 2  , STAGE_BYTES = 8 * HTB, NXCD = 8, WGM = 8;

__host__ __device__ __forceinline__ int lds_byte(int r, int c) { const int st = (r >> 4) * 2 + (c >> 5), rr = r & 15, cc = c & 31, ob = rr * 64 + cc * 2; return st * 1024 + (ob ^ (((ob >> 9) & 1) << 5)); }
__host__ __device__ __forceinline__ void stage_rc(int b, int& R, int& C) { const int st = b / 1024, sb = b % 1024, swz = sb ^ (((sb >> 9) & 1) << 5); R = (st >> 1) * 16 + swz / 64; C = (st & 1) * 32 + (swz % 64) / 2; }
__host__ __device__ __forceinline__ int perm32(int rho) { const int n = rho >> 4, i = rho & 15; return 8 * (i >> 2) + 4 * n + (i & 3); }

struct Unit { int pm, pn; };
struct Gemm { const bf16_t* A; const bf16_t* Bt; int M, N, K; int layA; };

struct StaticOrder {
    int nM, nN, nwg, G, c;
    __host__ __device__ void init(int M, int N, int G_, int c_) { nM = M / BM; nN = N / BM; nwg = nM * nN; G = G_; c = c_; }
    __host__ __device__ bool next(int i, Unit& u) const {
        const long L = (long)i * G + c; if (L >= nwg) return false;
        int wgid = (int)L; { const int q = nwg / NXCD, r = nwg % NXCD, xcd = wgid % NXCD, off = wgid / NXCD; wgid = (xcd < r ? xcd * (q + 1) : r * (q + 1) + (xcd - r) * q) + off; }
        const int nig = WGM * nN, gid = wgid / nig, fm = gid * WGM, gsz = (nM - fm) < WGM ? (nM - fm) : WGM;
        u.pm = fm + ((wgid % nig) % gsz); u.pn = (wgid % nig) / gsz; return true;
    }
    __device__ __forceinline__ void a_ready(const Unit&) const {}
    __device__ __forceinline__ void done(const Unit&) const {}
};

__device__ __forceinline__ unsigned cvt_pk_bf16(float lo, float hi) { unsigned r; asm volatile("v_cvt_pk_bf16_f32 %0, %1, %2" : "=v"(r) : "v"(lo), "v"(hi)); return r; }
typedef unsigned u32x2 __attribute__((ext_vector_type(2)));
struct EpiPlain {
    static constexpr bool PERM = true, AFTER_DRAIN = false, BREMAP = true;
    bf16_t* O; int ldc; const float* rs; PG8_LAS unsigned char* xl;
    static constexpr bool HAS_RS = true;
    __device__ __forceinline__ void load_rs(const Unit& u, int wr, int fr, float (&rsv)[8]) const {
#pragma unroll
        for (int i = 0; i < 8; ++i) rsv[i] = rs[u.pm * BM + wr * 64 + fr + (i >> 2) * HALF + (i & 3) * 16]; }
    __device__ __forceinline__ void operator()(const f32x4 (&acc)[2][2][4][2], const Unit& u, int wr, int wc, int fr, int fq, const float (&rsv)[8]) const {
        PG8_LAS unsigned char* wl = xl + (wr * 4 + wc) * 2304; const int lane = fq * 16 + fr, rr = lane >> 3, cc = lane & 7;
#pragma unroll
        for (int ai = 0; ai < 2; ++ai)
#pragma unroll
            for (int m = 0; m < 4; ++m) { const float sc = rsv[ai * 4 + m];
#pragma unroll
                for (int bj = 0; bj < 2; ++bj) { const f32x4 v0 = acc[ai][bj][m][0] * sc, v1 = acc[ai][bj][m][1] * sc;
                    u32x4 w; w.x = cvt_pk_bf16(v0[0], v0[1]); w.y = cvt_pk_bf16(v0[2], v0[3]); w.z = cvt_pk_bf16(v1[0], v1[1]); w.w = cvt_pk_bf16(v1[2], v1[3]);
                    *(PG8_LAS u32x4*)(wl + fr * 144 + bj * 64 + fq * 16) = w; }
                asm volatile("s_waitcnt lgkmcnt(0)" ::: "memory");
                const u32x4 r0 = *(const PG8_LAS u32x4*)(wl + rr * 144 + cc * 16), r1 = *(const PG8_LAS u32x4*)(wl + (rr + 8) * 144 + cc * 16);
                bf16_t* gp = O + (size_t)(u.pm * BM + ai * HALF + wr * 64 + m * 16 + rr) * ldc + u.pn * BM + wc * 64 + cc * 8;
                __builtin_nontemporal_store(r0, (u32x4*)gp); __builtin_nontemporal_store(r1, (u32x4*)(gp + (size_t)8 * ldc));
                asm volatile("s_waitcnt lgkmcnt(0)" ::: "memory");
            }
    }
};
struct EpiSS {
    static constexpr bool PERM = true, AFTER_DRAIN = false, BREMAP = false;
    bf16_t* O; int ldc; float* ss;
    static constexpr bool HAS_RS = false;
    __device__ __forceinline__ void operator()(const f32x4 (&acc)[2][2][4][2], const Unit& u, int wr, int wc, int fr, int fq, const float (&rsv)[8]) const {
        const int row0 = u.pm * BM + wr * 64 + fr; const int col0 = u.pn * BM + wc * 32 + 8 * fq;
#pragma unroll
        for (int ai = 0; ai < 2; ++ai)
#pragma unroll
            for (int m = 0; m < 4; ++m) { const int row = row0 + ai * HALF + m * 16; bf16_t* rowp = O + (size_t)row * ldc + col0; float s = 0.f;
#pragma unroll
                for (int bj = 0; bj < 2; ++bj) { const f32x4 v0 = acc[ai][bj][m][0], v1 = acc[ai][bj][m][1];
                    s += (v0[0] * v0[0] + v0[1] * v0[1]) + (v0[2] * v0[2] + v0[3] * v0[3]) + (v1[0] * v1[0] + v1[1] * v1[1]) + (v1[2] * v1[2] + v1[3] * v1[3]);
                    u32x4 w; w.x = cvt_pk_bf16(v0[0], v0[1]); w.y = cvt_pk_bf16(v0[2], v0[3]); w.z = cvt_pk_bf16(v1[0], v1[1]); w.w = cvt_pk_bf16(v1[2], v1[3]);
                    *(u32x4*)(rowp + bj * HALF) = w; }
                s += __shfl_xor(s, 16); s += __shfl_xor(s, 32);
                if (fq == 0) ss[(size_t)row * 16 + u.pn * 4 + wc] = s; }
    }
};
struct EpiSwiGLU {
    static constexpr bool PERM = true, AFTER_DRAIN = false, BREMAP = false;
    bf16_t* O; int ldc; const float* rs;
    static __device__ __forceinline__ float sg(float g, float up) { return g * __builtin_amdgcn_rcpf(1.0f + __expf(-g)) * up; }
    static constexpr bool HAS_RS = true;
    __device__ __forceinline__ void load_rs(const Unit& u, int wr, int fr, float (&rsv)[8]) const {
#pragma unroll
        for (int i = 0; i < 8; ++i) rsv[i] = rs[u.pm * BM + wr * 64 + fr + (i >> 2) * HALF + (i & 3) * 16]; }
    __device__ __forceinline__ void operator()(const f32x4 (&acc)[2][2][4][2], const Unit& u, int wr, int wc, int fr, int fq, const float (&rsv)[8]) const {
        const int row0 = u.pm * BM + wr * 64 + fr; const int col0 = u.pn * HALF + wc * 32 + 8 * fq;
#pragma unroll
        for (int ai = 0; ai < 2; ++ai)
#pragma unroll
            for (int m = 0; m < 4; ++m) { bf16_t* rowp = O + ((size_t)(u.pm * (ldc / HALF) + u.pn) << 15) + (size_t)(wc * 256 + wr * 64 + fr + ai * HALF + m * 16) * 32 + 8 * fq;
                const float sc = rsv[ai * 4 + m];
                const float ce = -1.4426950408889634f * sc, s2 = sc * sc;
                const f32x4 ga = acc[ai][0][m][0], gb = acc[ai][0][m][1];
                const f32x4 ta = ga * acc[ai][1][m][0] * s2, tb = gb * acc[ai][1][m][1] * s2, xa = ga * ce, xb = gb * ce;
                f32x4 ra, rb;
#pragma unroll
                for (int e = 0; e < 4; ++e) { ra[e] = __builtin_amdgcn_rcpf(1.0f + __builtin_amdgcn_exp2f(xa[e])); rb[e] = __builtin_amdgcn_rcpf(1.0f + __builtin_amdgcn_exp2f(xb[e])); }
                const f32x4 oa = ta * ra, ob = tb * rb;
                u32x4 w; w.x = cvt_pk_bf16(oa[0], oa[1]); w.y = cvt_pk_bf16(oa[2], oa[3]); w.z = cvt_pk_bf16(ob[0], ob[1]); w.w = cvt_pk_bf16(ob[2], ob[3]);
                __builtin_nontemporal_store(w, (u32x4*)rowp); }
    }
};

struct EpiFused {
    static constexpr bool PERM = true, AFTER_DRAIN = false, HAS_RS = false, BREMAP = false;
    bf16_t* XB; const float* gain; unsigned* xs; unsigned* part2; float* rs; unsigned* cnt1; unsigned* cnt2; float* out; int last; PG8_LAS unsigned char* xl;
    __device__ __forceinline__ void operator()(const f32x4 (&acc)[2][2][4][2], const Unit& u, int wr, int wc, int fr_, int fq_, const float (&rsv)[8]) const {
        int fr = fr_, fq = fq_; asm volatile("" : "+v"(fr), "+v"(fq));
        const int wid = wr * 4 + wc, lane = fq * 16 + fr;
        PG8_LAS float* P = (PG8_LAS float*)xl; PG8_LAS float* S = (PG8_LAS float*)(xl + 4096); PG8_LAS unsigned* flag = (PG8_LAS unsigned*)(xl + 5120);
#pragma unroll
        for (int ai = 0; ai < 2; ++ai)
#pragma unroll
            for (int m = 0; m < 4; ++m) { float s = 0.f;
#pragma unroll
                for (int bj = 0; bj < 2; ++bj)
#pragma unroll
                    for (int n = 0; n < 2; ++n) { const f32x4 v = acc[ai][bj][m][n]; s += (v[0] * v[0] + v[1] * v[1]) + (v[2] * v[2] + v[3] * v[3]); }
                s += __shfl_xor(s, 16); s += __shfl_xor(s, 32);
                if (fq == 0) P[(ai * HALF + wr * 64 + m * 16 + fr) * 4 + wc] = s; }
        asm volatile("s_waitcnt lgkmcnt(0)" ::: "memory"); __builtin_amdgcn_s_barrier(); asm volatile("" ::: "memory");
        const int prow = (wid & 3) * 64 + lane; const size_t slot = ((size_t)u.pm * BM + prow) * 4;
        if (wid < 4) { const float tp = (P[prow * 4 + 0] + P[prow * 4 + 1]) + (P[prow * 4 + 2] + P[prow * 4 + 3]);
            __hip_atomic_store(xs + slot + u.pn, __float_as_uint(tp), __ATOMIC_RELAXED, __HIP_MEMORY_SCOPE_AGENT); }
        asm volatile("s_waitcnt vmcnt(0)" ::: "memory");
        if (wid < 4 && lane == 0) __hip_atomic_fetch_add(cnt1 + 16 * u.pm, 1u, __ATOMIC_RELAXED, __HIP_MEMORY_SCOPE_AGENT);
        const int cb = u.pn * BM + wc * 32 + 8 * fq;
        u32x4 xw[2][4][2];
#pragma unroll
        for (int ai = 0; ai < 2; ++ai)
#pragma unroll
            for (int m = 0; m < 4; ++m)
#pragma unroll
                for (int bj = 0; bj < 2; ++bj) xw[ai][m][bj] = *(const u32x4*)(XB + ((size_t)u.pm * BM + ai * HALF + wr * 64 + m * 16 + fr) * 1024 + cb + bj * HALF);
        if (wid == 0) { unsigned sp = 0u;
            while (__hip_atomic_load(cnt1 + 16 * u.pm, __ATOMIC_RELAXED, __HIP_MEMORY_SCOPE_AGENT) < 16u) { __builtin_amdgcn_s_sleep(2); if (++sp > (1u << 20)) break; }
            __builtin_amdgcn_fence(__ATOMIC_ACQUIRE, "agent"); }
        asm volatile("s_waitcnt vmcnt(0) lgkmcnt(0)" ::: "memory"); __builtin_amdgcn_s_barrier(); asm volatile("" ::: "memory");
        if (wid < 4) { float t = 0.f;
#pragma unroll
            for (int k = 0; k < 4; ++k) t += __uint_as_float(__hip_atomic_load(xs + slot + k, __ATOMIC_RELAXED, __HIP_MEMORY_SCOPE_AGENT));
            S[prow] = rsqrtf(t * (1.0f / 1024.0f) + 1e-6f); }
        asm volatile("s_waitcnt vmcnt(0) lgkmcnt(0)" ::: "memory"); __builtin_amdgcn_s_barrier(); asm volatile("" ::: "memory");
        f32x4 g[2][2];
#pragma unroll
        for (int bj = 0; bj < 2; ++bj) { g[bj][0] = *(const f32x4*)(gain + cb + bj * HALF); g[bj][1] = *(const f32x4*)(gain + cb + bj * HALF + 4); }
#pragma unroll
        for (int ai = 0; ai < 2; ++ai)
#pragma unroll
            for (int m = 0; m < 4; ++m) { const int rl = ai * HALF + wr * 64 + m * 16 + fr; const size_t grow = (size_t)u.pm * BM + rl; const float rsm = S[rl]; float s2 = 0.f;
#pragma unroll
                for (int bj = 0; bj < 2; ++bj) { bf16_t* xp = XB + grow * 1024 + cb + bj * HALF; const u32x4 xq = xw[ai][m][bj];
                    const f32x4 a0 = acc[ai][bj][m][0] * rsm * g[bj][0], a1 = acc[ai][bj][m][1] * rsm * g[bj][1];
                    f32x4 v0, v1; v0[0] = __uint_as_float(xq.x << 16) + a0[0]; v0[1] = __uint_as_float(xq.x & 0xffff0000u) + a0[1]; v0[2] = __uint_as_float(xq.y << 16) + a0[2]; v0[3] = __uint_as_float(xq.y & 0xffff0000u) + a0[3];
                    v1[0] = __uint_as_float(xq.z << 16) + a1[0]; v1[1] = __uint_as_float(xq.z & 0xffff0000u) + a1[1]; v1[2] = __uint_as_float(xq.w << 16) + a1[2]; v1[3] = __uint_as_float(xq.w & 0xffff0000u) + a1[3];
                    s2 += (v0[0] * v0[0] + v0[1] * v0[1]) + (v0[2] * v0[2] + v0[3] * v0[3]) + (v1[0] * v1[0] + v1[1] * v1[1]) + (v1[2] * v1[2] + v1[3] * v1[3]);
                    if (!last) { u32x4 w; w.x = cvt_pk_bf16(v0[0], v0[1]); w.y = cvt_pk_bf16(v0[2], v0[3]); w.z = cvt_pk_bf16(v1[0], v1[1]); w.w = cvt_pk_bf16(v1[2], v1[3]); __builtin_nontemporal_store(w, (u32x4*)xp); }
                    else { float* op = out + grow * 1024 + cb + bj * HALF; __builtin_nontemporal_store(v0, (f32x4*)op); __builtin_nontemporal_store(v1, (f32x4*)(op + 4)); } }
                s2 += __shfl_xor(s2, 16); s2 += __shfl_xor(s2, 32);
                if (fq == 0) P[rl * 4 + wc] = s2;
                }
        if (!last) {
            asm volatile("s_waitcnt lgkmcnt(0)" ::: "memory"); __builtin_amdgcn_s_barrier(); asm volatile("" ::: "memory");
            if (wid < 4) { const float tp = (P[prow * 4 + 0] + P[prow * 4 + 1]) + (P[prow * 4 + 2] + P[prow * 4 + 3]);
                __hip_atomic_store(part2 + slot + u.pn, __float_as_uint(tp), __ATOMIC_RELAXED, __HIP_MEMORY_SCOPE_AGENT); }
            asm volatile("s_waitcnt vmcnt(0) lgkmcnt(0)" ::: "memory"); __builtin_amdgcn_s_barrier(); asm volatile("" ::: "memory");
            if (wid == 0) { unsigned old = 0u; if (lane == 0) old = __hip_atomic_fetch_add(cnt2 + 16 * u.pm, 1u, __ATOMIC_RELAXED, __HIP_MEMORY_SCOPE_AGENT);
                old = (unsigned)__builtin_amdgcn_readfirstlane((int)old);
                if (old == 3u) __builtin_amdgcn_fence(__ATOMIC_ACQUIRE, "agent");
                if (lane == 0) flag[0] = (old == 3u) ? 1u : 0u; }
            asm volatile("s_waitcnt vmcnt(0) lgkmcnt(0)" ::: "memory"); __builtin_amdgcn_s_barrier(); asm volatile("" ::: "memory");
            if (flag[0] != 0u && wid < 4) { float t = 0.f;
#pragma unroll
                for (int k = 0; k < 4; ++k) t += __uint_as_float(__hip_atomic_load(part2 + slot + k, __ATOMIC_RELAXED, __HIP_MEMORY_SCOPE_AGENT));
                rs[(size_t)u.pm * BM + prow] = rsqrtf(t * (1.0f / 1024.0f) + 1e-6f); }
        }
    }
};

template <class Epi, class Sched, bool ALIGN_EPI = false, bool SP2 = false>
__device__ __forceinline__ void gemm_phase(PG8_LAS unsigned char* lds, const Gemm g, const Sched& S, const Epi& E) {
    int tid_ = threadIdx.x; asm volatile("" : "+v"(tid_));
    const int tid = tid_, wid = __builtin_amdgcn_readfirstlane(tid >> 6), lane = tid & 63, wr = wid >> 2, wc = wid & 3, fr = lane & 15, fq = lane >> 4;
    const int K = g.K, nt = K / BK;
    unsigned voffA[2], voffB[2];
#pragma unroll
    for (int i = 0; i < 2; ++i) { int R, C; stage_rc(tid * 16 + i * 8192, R, C); const int Rb = Epi::BREMAP ? (64 * (R >> 5) + perm32(R & 31)) : (Epi::PERM ? ((R & ~31) + perm32(R & 31)) : R);
        voffA[i] = g.layA ? (unsigned)((((C >> 5) * 256 + R) * 32 + (C & 31)) * 2) : (unsigned)(R * K + C) * 2u; voffB[i] = (unsigned)(Rb * K + C) * 2u; }
    const size_t kstep = (size_t)(BK * 2);
    const size_t hstep = (size_t)HALF * K * 2;
    const size_t hstepA = g.layA ? (size_t)HALF * 64 : hstep, kt1A = g.layA ? (size_t)32768 : kstep, kblkA = g.layA ? (size_t)65536 : 2 * kstep;
    const size_t hstepB = Epi::BREMAP ? (size_t)32 * K * 2 : hstep;
    const size_t tstep = 2 * hstep;
    const unsigned ldsw = (unsigned)wid * 1024u;
    const int aoff = lds_byte(wr * 64 + fr, fq * 8), boff = lds_byte(wc * 32 + fr, fq * 8);
#define PG8_SA(b, h) (((b) * 2 + (h)) * HTB)
#define PG8_SB(b, h) ((4 + (b) * 2 + (h)) * HTB)
#define PG8_STAGE(bufoff, gbase, voff) do { _Pragma("unroll") for (int _i = 0; _i < 2; ++_i) \
        __builtin_amdgcn_global_load_lds((const unsigned*)((const char*)(gbase) + (voff)[_i]), (PG8_LAS unsigned*)(lds + (bufoff) + ldsw + _i * 8192), 16, 0, 0); } while (0)
#define PG8_LDA(dst, b, h) do { _Pragma("unroll") for (int m = 0; m < 4; ++m) _Pragma("unroll") for (int k = 0; k < 2; ++k) dst[m][k] = *(const PG8_LAS bf16x8*)(lds + PG8_SA(b, h) + aoff + m * 2048 + k * 1024); } while (0)
#define PG8_LDB(dst, b, h) do { _Pragma("unroll") for (int n = 0; n < 2; ++n) _Pragma("unroll") for (int k = 0; k < 2; ++k) dst[n][k] = *(const PG8_LAS bf16x8*)(lds + PG8_SB(b, h) + boff + n * 2048 + k * 1024); } while (0)
#define PG8_MMA(ai, bj, At, Bt) do { __builtin_amdgcn_s_setprio(1); _Pragma("unroll") for (int m = 0; m < 4; ++m) _Pragma("unroll") for (int n = 0; n < 2; ++n) _Pragma("unroll") for (int k = 0; k < 2; ++k) \
        acc[ai][bj][m][n] = __builtin_amdgcn_mfma_f32_16x16x32_bf16(Bt[n][k], At[m][k], acc[ai][bj][m][n], 0, 0, 0); __builtin_amdgcn_s_setprio(0); } while (0)
#define PG8_WAIT_V(n) asm volatile("s_waitcnt vmcnt(" #n ")" ::: "memory")
#define PG8_WAIT_L(n) asm volatile("s_waitcnt lgkmcnt(" #n ")" ::: "memory")
#define PG8_BAR __builtin_amdgcn_s_barrier()
#define PG8_SCHED __builtin_amdgcn_sched_barrier(0)
    Unit cur, nxt; int ui = 0;
    if (!S.next(0, cur)) return;
    f32x4 acc[2][2][4][2];
#pragma unroll
    for (int a = 0; a < 2; ++a)
#pragma unroll
        for (int b = 0; b < 2; ++b)
#pragma unroll
            for (int m = 0; m < 4; ++m)
#pragma unroll
                for (int n = 0; n < 2; ++n) acc[a][b][m][n] = (f32x4){0.f, 0.f, 0.f, 0.f};
    bf16x8 At[4][2], B0[2][2], B1[2][2]; float rsv[8];
#pragma unroll
    for (int i = 0; i < 8; ++i) rsv[i] = 1.0f;
    const char* cA = (const char*)g.A + (size_t)cur.pm * tstep; const char* cB = (const char*)g.Bt + (size_t)cur.pn * tstep;
    S.a_ready(cur);
    if constexpr (SP2) {
        PG8_STAGE(PG8_SB(0, 0), cB, voffB); PG8_STAGE(PG8_SB(0, 1), cB + hstepB, voffB); PG8_STAGE(PG8_SA(0, 0), cA, voffA); PG8_STAGE(PG8_SA(0, 1), cA + hstepA, voffA);
        if (wr == 1) PG8_BAR;
        PG8_WAIT_V(2); PG8_BAR;
        PG8_STAGE(PG8_SB(1, 0), cB + kstep, voffB); PG8_STAGE(PG8_SA(1, 0), cA + kt1A, voffA); PG8_STAGE(PG8_SB(1, 1), cB + hstepB + kstep, voffB);
        PG8_WAIT_V(6); PG8_BAR;
    } else {
        PG8_STAGE(PG8_SB(0, 0), cB, voffB); PG8_STAGE(PG8_SA(0, 0), cA, voffA); PG8_STAGE(PG8_SB(0, 1), cB + hstepB, voffB); PG8_STAGE(PG8_SA(0, 1), cA + hstep, voffA);
        if (wr == 1) PG8_BAR;
        PG8_WAIT_V(4); PG8_BAR;
        PG8_STAGE(PG8_SB(1, 0), cB + kstep, voffB); PG8_STAGE(PG8_SA(1, 0), cA + kstep, voffA); PG8_STAGE(PG8_SB(1, 1), cB + hstepB + kstep, voffB);
        PG8_WAIT_V(6); PG8_BAR;
    }
    for (;;) {
        const bool has_next = S.next(ui + 1, nxt);
        const char* nA = has_next ? (const char*)g.A + (size_t)nxt.pm * tstep : cA; const char* nB = has_next ? (const char*)g.Bt + (size_t)nxt.pn * tstep : cB;
        for (int t = 0; t < nt; t += 2) {
            const bool last = (t == nt - 2);
            const char* a1 = cA + (size_t)(t >> 1) * kblkA + kt1A;
            const char* a2 = last ? nA : cA + (size_t)((t >> 1) + 1) * kblkA; const char* b2 = last ? nB : cB + (size_t)(t + 2) * kstep;
            const char* a3 = a2 + kt1A; const char* b3 = b2 + kstep;
            if (last && has_next) S.a_ready(nxt);
            if constexpr (Epi::HAS_RS) { if (last) E.load_rs(cur, wr, fr, rsv); }
            if constexpr (SP2) {
            PG8_LDB(B0, 0, 0); PG8_LDB(B1, 0, 1); PG8_SCHED; PG8_LDA(At, 0, 0); PG8_STAGE(PG8_SA(1, 1), a1 + hstepA, voffA);
            PG8_WAIT_V(8); PG8_WAIT_L(0); PG8_BAR; PG8_MMA(0, 0, At, B0); PG8_MMA(0, 1, At, B1); PG8_BAR; PG8_SCHED;
            PG8_LDA(At, 0, 1); PG8_STAGE(PG8_SB(0, 0), b2, voffB); PG8_STAGE(PG8_SB(0, 1), b2 + hstepB, voffB); PG8_STAGE(PG8_SA(0, 0), a2, voffA);
            PG8_WAIT_V(8); PG8_WAIT_L(0); PG8_BAR; PG8_MMA(1, 0, At, B0); PG8_MMA(1, 1, At, B1); PG8_BAR; PG8_SCHED;
            PG8_LDB(B0, 1, 0); PG8_LDB(B1, 1, 1); PG8_SCHED; PG8_LDA(At, 1, 0); PG8_STAGE(PG8_SA(0, 1), a2 + hstepA, voffA);
            PG8_WAIT_V(8); PG8_WAIT_L(0); PG8_BAR; PG8_MMA(0, 0, At, B0); PG8_MMA(0, 1, At, B1); PG8_BAR; PG8_SCHED;
            PG8_LDA(At, 1, 1); PG8_STAGE(PG8_SB(1, 0), b3, voffB); PG8_STAGE(PG8_SB(1, 1), b3 + hstepB, voffB); PG8_STAGE(PG8_SA(1, 0), a3, voffA);
            PG8_WAIT_V(8); PG8_WAIT_L(0); PG8_BAR; PG8_MMA(1, 0, At, B0); PG8_MMA(1, 1, At, B1); PG8_BAR; PG8_SCHED;
            } else {
            PG8_LDB(B0, 0, 0); PG8_SCHED; PG8_LDA(At, 0, 0); PG8_STAGE(PG8_SA(1, 1), a1 + hstepA, voffA);
            PG8_WAIT_L(8); PG8_BAR; PG8_WAIT_L(0); PG8_MMA(0, 0, At, B0); PG8_BAR; PG8_SCHED;
            PG8_LDB(B1, 0, 1); PG8_STAGE(PG8_SB(0, 0), b2, voffB);
            PG8_BAR; PG8_WAIT_L(0); PG8_MMA(0, 1, At, B1); PG8_BAR;
            PG8_LDA(At, 0, 1); PG8_STAGE(PG8_SA(0, 0), a2, voffA);
            PG8_BAR; PG8_WAIT_L(0); PG8_MMA(1, 0, At, B0); PG8_BAR; PG8_SCHED;
            PG8_STAGE(PG8_SB(0, 1), b2 + hstepB, voffB);
            PG8_WAIT_V(6); PG8_BAR; PG8_MMA(1, 1, At, B1); PG8_BAR;
            PG8_LDB(B0, 1, 0); PG8_SCHED; PG8_LDA(At, 1, 0); PG8_STAGE(PG8_SA(0, 1), a2 + hstepA, voffA);
            PG8_WAIT_L(8); PG8_BAR; PG8_WAIT_L(0); PG8_MMA(0, 0, At, B0); PG8_BAR; PG8_SCHED;
            PG8_LDB(B1, 1, 1); PG8_STAGE(PG8_SB(1, 0), b3, voffB);
            PG8_BAR; PG8_WAIT_L(0); PG8_MMA(0, 1, At, B1); PG8_BAR;
            PG8_LDA(At, 1, 1); PG8_STAGE(PG8_SA(1, 0), a3, voffA);
            PG8_BAR; PG8_WAIT_L(0); PG8_MMA(1, 0, At, B0); PG8_BAR; PG8_SCHED;
            PG8_STAGE(PG8_SB(1, 1), b3 + hstepB, voffB);
            PG8_WAIT_V(6); PG8_BAR; PG8_MMA(1, 1, At, B1); PG8_BAR;
            }
        }
        if constexpr (ALIGN_EPI) { if (wr == 0) PG8_BAR; }
        if constexpr (!Epi::AFTER_DRAIN) { E(acc, cur, wr, wc, fr, fq, rsv); S.done(cur); }
        if (!has_next) break;
#pragma unroll
        for (int a = 0; a < 2; ++a)
#pragma unroll
            for (int b = 0; b < 2; ++b)
#pragma unroll
                for (int m = 0; m < 4; ++m)
#pragma unroll
                    for (int n = 0; n < 2; ++n) acc[a][b][m][n] = (f32x4){0.f, 0.f, 0.f, 0.f};
        cur = nxt; cA = nA; cB = nB; ++ui;
        if constexpr (ALIGN_EPI) { if (wr == 1) PG8_BAR; }
    }
    PG8_WAIT_V(0);
    if constexpr (!ALIGN_EPI) { if (wr == 0) PG8_BAR; }
    PG8_BAR;
    if constexpr (Epi::AFTER_DRAIN) { E.fused(acc, cur, wr, wc, fr, fq, lds, wid, lane); S.done(cur); }
#undef PG8_SA
#undef PG8_SB
#undef PG8_STAGE
#undef PG8_LDA
#undef PG8_LDB
#undef PG8_MMA
#undef PG8_WAIT_V
#undef PG8_WAIT_L
#undef PG8_BAR
#undef PG8_SCHED
}
}
constexpr int NWAVES = 8, NTHR = 512;
constexpr int BATCH = 8, SEQ = 8192, DM = 1024, MTOK = BATCH * SEQ, PROJ = 1792, FF = 2816, NGU = 2 * FF, DEPTH = 2;
constexpr float EPS = 1e-6f;
constexpr size_t MiB = 1u << 20, KiB = 1024;
constexpr size_t WS_CTL = 0, WS_TAB = 1 * MiB, WS_W = 4 * MiB, WS_HB = 64 * MiB, WS_PROJ = 192 * MiB, WS_Y = 416 * MiB, WS_ACT = 192 * MiB, WS_MB = 544 * MiB,
                 WS_H = 672 * MiB, WS_A = 736 * MiB, WS_SS = 770 * MiB, WS_RS = 774 * MiB, WS_XS = 775 * MiB, WS_P2 = 776 * MiB, WS_END = 777 * MiB;
constexpr int CW_CNT = 4096, CW_CNT_SET = 4096, CW_WORDS = CW_CNT + 8 * CW_CNT_SET;
constexpr size_t TAB_TT = 0, TAB_TW = 64 * KiB, TAB_L = 128 * KiB, TAB_LSTRIDE = 512 * KiB, TAB_POOLT = 0, TAB_FWT = 32 * KiB, TAB_SPW = 64 * KiB;
constexpr size_t W_LSTRIDE = 22 * MiB, W_IN = 0, W_OUT = 3 * MiB + 512 * KiB, W_GU = 5 * MiB + 512 * KiB, W_DN = 16 * MiB + 512 * KiB;
static_assert(WS_PROJ + (size_t)MTOK * PROJ * 2 == WS_Y && WS_ACT + (size_t)MTOK * FF * 2 == WS_MB && WS_W + DEPTH * W_LSTRIDE <= WS_HB, "ws map");
constexpr int LDS_BYTES = 149568;
constexpr int NPHASE = 1 + 9 * DEPTH;
#ifndef M1_REP
#define M1_REP 0
#endif
#ifndef FUSE_E
#define FUSE_E 1
#endif
#ifndef MK_SINGLE
#define MK_SINGLE 1
#endif

#define LAS __attribute__((address_space(3)))
typedef unsigned short bf16;
typedef unsigned u32x4 __attribute__((ext_vector_type(4)));
typedef unsigned u32x2 __attribute__((ext_vector_type(2)));
typedef float f32x4 __attribute__((ext_vector_type(4)));
typedef float f32x2 __attribute__((ext_vector_type(2)));
typedef short bf16x8 __attribute__((ext_vector_type(8)));

__device__ __forceinline__ unsigned f2bf(float f) { unsigned u = __float_as_uint(f); return (u + 0x7fffu + ((u >> 16) & 1u)) >> 16; }
__device__ __forceinline__ unsigned pk2(float lo, float hi) { return pg8::cvt_pk_bf16(lo, hi); }
__device__ __forceinline__ float bf_lo(unsigned w) { return __uint_as_float(w << 16); }
__device__ __forceinline__ float bf_hi(unsigned w) { return __uint_as_float(w & 0xffff0000u); }
__device__ __forceinline__ void unpack8(const u32x4 w, float (&f)[8]) { f[0] = bf_lo(w.x); f[1] = bf_hi(w.x); f[2] = bf_lo(w.y); f[3] = bf_hi(w.y); f[4] = bf_lo(w.z); f[5] = bf_hi(w.z); f[6] = bf_lo(w.w); f[7] = bf_hi(w.w); }
__device__ __forceinline__ u32x4 pack8(const float (&f)[8]) { u32x4 w; w.x = pk2(f[0], f[1]); w.y = pk2(f[2], f[3]); w.z = pk2(f[4], f[5]); w.w = pk2(f[6], f[7]); return w; }
__device__ __forceinline__ float wave_sum(float v) {
#pragma unroll
    for (int o = 1; o < 64; o <<= 1) v += __shfl_xor(v, o);
    return v;
}
#define MFMA16(a, b, c) __builtin_amdgcn_mfma_f32_16x16x32_bf16((a), (b), (c), 0, 0, 0)

struct Args { const float* in[17]; float* out; unsigned char* ws; int ph_lo, ph_hi; };

struct Ctx {
    LAS unsigned char* lds; int tid, lane, wave, G, bid;
    unsigned char* ws;
};

__device__ __forceinline__ void transpose_item(const float* W, int K, int N, int k0, int n0, bf16* WT, int dst_row0, const float* gain, LAS float* scr, int lane) {
    { const int kq = lane >> 3, nq = lane & 7; f32x4 v[8]; float g[8];
#pragma unroll
      for (int i = 0; i < 8; ++i) { v[i] = *(const f32x4*)(W + (size_t)(k0 + 8 * i + kq) * N + n0 + 4 * nq); g[i] = gain ? gain[k0 + 8 * i + kq] : 1.0f; }
#pragma unroll
      for (int i = 0; i < 8; ++i) { LAS float* d = scr + (8 * i + kq) * 33 + 4 * nq; d[0] = v[i][0] * g[i]; d[1] = v[i][1] * g[i]; d[2] = v[i][2] * g[i]; d[3] = v[i][3] * g[i]; } }
    asm volatile("s_waitcnt lgkmcnt(0)" ::: "memory");
    const int c = lane & 7;
#pragma unroll
    for (int j = 0; j < 4; ++j) { const int n = (lane >> 3) + 8 * j; const LAS float* s = scr + (8 * c) * 33 + n;
        u32x4 o; o.x = pk2(s[0 * 33], s[1 * 33]); o.y = pk2(s[2 * 33], s[3 * 33]); o.z = pk2(s[4 * 33], s[5 * 33]); o.w = pk2(s[6 * 33], s[7 * 33]);
        *(u32x4*)(WT + (size_t)(dst_row0 + n) * K + k0 + 8 * c) = o; }
    asm volatile("s_waitcnt lgkmcnt(0)" ::: "memory");
}
__device__ __forceinline__ void rms_row_to_bf16(const float* xrow, bf16* orow, float* rsp, int lane) {
    const f32x4* xr = (const f32x4*)xrow + lane; f32x4 v[4]; float s = 0.f;
#pragma unroll
    for (int j = 0; j < 4; ++j) { v[j] = xr[64 * j]; s += (v[j].x * v[j].x + v[j].y * v[j].y) + (v[j].z * v[j].z + v[j].w * v[j].w); }
    const float rs = rsqrtf(wave_sum(s) * (1.f / DM) + EPS);
    if (lane == 0) *rsp = rs;
    u32x2* o8 = (u32x2*)orow + lane;
#pragma unroll
    for (int j = 0; j < 4; ++j) { u32x2 w; w.x = pk2(v[j].x, v[j].y); w.y = pk2(v[j].z, v[j].w); o8[64 * j] = w; }
}
__device__ __forceinline__ void p_prologue(Ctx& F, const Args& AR) {
    LAS float* scr = (LAS float*)(F.lds + F.wave * 16384);
    const int gw = F.bid * NWAVES + F.wave, NGW = F.G * NWAVES;
    constexpr int I_IN = 16 * (PROJ / 32), I_OUT = 16 * (DM / 32), I_G = 16 * (FF / 32), I_D = (FF / 64) * (DM / 32), I_L = I_IN + I_OUT + 2 * I_G + I_D;
    for (int it = gw; it < DEPTH * I_L; it += NGW) {
        const int l = it / I_L; int r = it % I_L;
        bf16* wl = (bf16*)(F.ws + WS_W + (size_t)l * W_LSTRIDE);
        if (r < I_IN) { const int nb = PROJ / 32, kb = r / nb, n0 = (r % nb) * 32; transpose_item(AR.in[5] + (size_t)l * DM * PROJ, DM, PROJ, kb * 64, n0, (bf16*)((unsigned char*)wl + W_IN), n0, AR.in[1] + l * DM, scr, F.lane); continue; } r -= I_IN;
        if (r < I_OUT) { const int nb = DM / 32, kb = r / nb, n0 = (r % nb) * 32; transpose_item(AR.in[13] + (size_t)l * DM * DM, DM, DM, kb * 64, n0, (bf16*)((unsigned char*)wl + W_OUT), n0, AR.in[12] + l * DM, scr, F.lane); continue; } r -= I_OUT;
        if (r < I_G) { const int nb = FF / 32, kb = r / nb, n0 = (r % nb) * 32; transpose_item(AR.in[14] + (size_t)l * DM * FF, DM, FF, kb * 64, n0, (bf16*)((unsigned char*)wl + W_GU), 256 * (n0 / 128) + (n0 % 128), AR.in[3] + l * DM, scr, F.lane); continue; } r -= I_G;
        if (r < I_G) { const int nb = FF / 32, kb = r / nb, n0 = (r % nb) * 32; transpose_item(AR.in[15] + (size_t)l * DM * FF, DM, FF, kb * 64, n0, (bf16*)((unsigned char*)wl + W_GU), 256 * (n0 / 128) + 128 + (n0 % 128), AR.in[3] + l * DM, scr, F.lane); continue; } r -= I_G;
        { const int nb = DM / 32, kb = r / nb, n0 = (r % nb) * 32; transpose_item(AR.in[16] + (size_t)l * FF * DM, FF, DM, kb * 64, n0, (bf16*)((unsigned char*)wl + W_DN), n0, nullptr, scr, F.lane); }
    }
    const int gt = F.bid * NTHR + F.tid, GT = F.G * NTHR;
    bf16* TT = (bf16*)(F.ws + WS_TAB + TAB_TT); f32x2* TW = (f32x2*)(F.ws + WS_TAB + TAB_TW);
    for (int i = gt; i < 4096; i += GT) {
        const int n = i >> 6, c = i & 63, col = n >> 1, part = n & 1; float v;
        if (col == 0) v = part ? ((c & 1) ? -1.f : 1.f) : 1.f;
        else { const float a = (float)((col * c) & 63) * (1.0f / 32.0f); v = part ? -sinpif(a) : cospif(a); }
        TT[i] = (bf16)f2bf(v);
        const float b = (float)i * (1.0f / 4096.0f); TW[i] = (f32x2){cospif(b), -sinpif(b)};
    }
    for (int l = 0; l < DEPTH; ++l) {
        unsigned char* tl = F.ws + WS_TAB + TAB_L + (size_t)l * TAB_LSTRIDE;
        bf16* POOLT = (bf16*)(tl + TAB_POOLT); bf16* FWT = (bf16*)(tl + TAB_FWT); bf16* SPW = (bf16*)(tl + TAB_SPW);
        const float* pw = AR.in[7] + (size_t)l * 4 * 64 * 64; const float* ps = AR.in[8] + l * 256; const float* fw = AR.in[9] + (size_t)l * 4 * 64 * 64; const float* sw = AR.in[10] + (size_t)l * 4 * 128 * 128;
        for (int i = gt; i < 16384; i += GT) { const int g = i >> 12, dd = (i >> 6) & 63, c = i & 63;
            POOLT[i] = (bf16)f2bf(pw[(g * 64 + c) * 64 + dd] * ps[g * 64 + dd]);
            FWT[i] = (bf16)f2bf(fw[(g * 64 + c) * 64 + dd] * 0.001381067932f); }
        for (int i = gt; i < 65536; i += GT) SPW[i] = (bf16)f2bf(sw[i]);
    }
    bf16* HB = (bf16*)(F.ws + WS_HB);
    float* RS = (float*)(F.ws + WS_RS);
    for (int m0 = gw * 4; m0 < MTOK; m0 += NGW * 4) {
        f32x4 v[4][4];
#pragma unroll
        for (int r = 0; r < 4; ++r)
#pragma unroll
            for (int j = 0; j < 4; ++j) v[r][j] = ((const f32x4*)(AR.in[0] + (size_t)(m0 + r) * DM))[F.lane + 64 * j];
#pragma unroll
        for (int r = 0; r < 4; ++r) { float s = 0.f;
#pragma unroll
            for (int j = 0; j < 4; ++j) s += (v[r][j].x * v[r][j].x + v[r][j].y * v[r][j].y) + (v[r][j].z * v[r][j].z + v[r][j].w * v[r][j].w);
            const float rs = rsqrtf(wave_sum(s) * (1.f / DM) + EPS); if (F.lane == 0) RS[m0 + r] = rs;
            u32x2* o8 = (u32x2*)(HB + (size_t)(m0 + r) * DM) + F.lane;
#pragma unroll
            for (int j = 0; j < 4; ++j) { u32x2 w; w.x = pk2(v[r][j].x, v[r][j].y); w.y = pk2(v[r][j].z, v[r][j].w); o8[64 * j] = w; } }
    }
}

__device__ __forceinline__ void conv8(const bf16* pr, int ch, bool hasL, bool hasR, const float* convw, float (&y)[8]) {
    const u32x4 zero4 = (u32x4){0u, 0u, 0u, 0u};
    float b8[8], c0[8], z0[8], cl[8], zl[8], cr[8], zr[8];
    unpack8(*(const u32x4*)(pr + ch), b8); unpack8(*(const u32x4*)(pr + 256 + ch), c0); unpack8(*(const u32x4*)(pr + 512 + ch), z0);
    unpack8(hasL ? *(const u32x4*)(pr - PROJ + 256 + ch) : zero4, cl); unpack8(hasL ? *(const u32x4*)(pr - PROJ + 512 + ch) : zero4, zl);
    unpack8(hasR ? *(const u32x4*)(pr + PROJ + 256 + ch) : zero4, cr); unpack8(hasR ? *(const u32x4*)(pr + PROJ + 512 + ch) : zero4, zr);
    const f32x4 wa0 = *(const f32x4*)(convw + ch), wa1 = *(const f32x4*)(convw + ch + 4), wb0 = *(const f32x4*)(convw + 256 + ch), wb1 = *(const f32x4*)(convw + 256 + ch + 4), wc0 = *(const f32x4*)(convw + 512 + ch), wc1 = *(const f32x4*)(convw + 512 + ch + 4);
#pragma unroll
    for (int e = 0; e < 8; ++e) { const float w0 = e < 4 ? wa0[e & 3] : wa1[e & 3], w1 = e < 4 ? wb0[e & 3] : wb1[e & 3], w2 = e < 4 ? wc0[e & 3] : wc1[e & 3];
        y[e] = b8[e] * (w0 * (cl[e] * zl[e]) + w1 * (c0[e] * z0[e]) + w2 * (cr[e] * zr[e])); }
}
constexpr int VROW = 272;
constexpr int PTROW = 528;
__device__ __forceinline__ void p_mix_gmlp(Ctx& F, const Args& AR, int l) {
    const bf16* proj = (const bf16*)(F.ws + WS_PROJ); bf16* Y = (bf16*)(F.ws + WS_Y);
    const bf16* SPW = (const bf16*)(F.ws + WS_TAB + TAB_L + (size_t)l * TAB_LSTRIDE + TAB_SPW); const float* spb = AR.in[11] + l * 4 * 128;
    const int tid = F.tid, lane = F.lane, fr = lane & 15, fq = lane >> 4, p0 = F.wave * 16;
    const int lq = tid & 127, lh = tid >> 7;
    u32x4 vpre[8];
    if (F.bid < MTOK / 128) {
#pragma unroll
        for (int i = 0; i < 8; ++i) vpre[i] = *(const u32x4*)(proj + (size_t)(F.bid * 128 + lq) * PROJ + 1536 + lh * 64 + 8 * i); }
    for (int chunk = F.bid; chunk < MTOK / 128; chunk += F.G) {
        const int R0 = chunk * 128;
        { const int q = lq, h = lh;
          float v[64]; float s = 0.f;
#pragma unroll
          for (int i = 0; i < 8; ++i) { const u32x4 w = vpre[i]; float f[8]; unpack8(w, f);
#pragma unroll
              for (int e = 0; e < 8; ++e) { v[8 * i + e] = f[e]; s += f[e]; } }
          const float mu = s * (1.f / 64.f); float s2 = 0.f;
#pragma unroll
          for (int c = 0; c < 64; ++c) { v[c] -= mu; s2 += v[c] * v[c]; }
          const float rstd = rsqrtf(s2 * (1.f / 64.f) + EPS);
#pragma unroll
          for (int c = 0; c < 64; c += 2) { const unsigned w = pk2(v[c] * rstd, v[c + 1] * rstd);
              *(LAS unsigned short*)(F.lds + (h * 64 + c) * VROW + q * 2) = (unsigned short)w; *(LAS unsigned short*)(F.lds + (h * 64 + c + 1) * VROW + q * 2) = (unsigned short)(w >> 16); }
        }
        __syncthreads();
        const size_t row = (size_t)R0 + p0 + fr; const bf16* pr = proj + row * PROJ; bf16* yr = Y + row * DM;
        { f32x4 acc[16];
#pragma unroll
          for (int i = 0; i < 16; ++i) acc[i] = (f32x4){0.f, 0.f, 0.f, 0.f};
          u32x2 uw[16]; float bias[4];
#pragma unroll
          for (int ct = 0; ct < 16; ++ct) uw[ct] = *(const u32x2*)(pr + 1280 + ct * 16 + 4 * fq);
          if (chunk + F.G < MTOK / 128) {
#pragma unroll
              for (int i = 0; i < 8; ++i) vpre[i] = *(const u32x4*)(proj + (size_t)((chunk + F.G) * 128 + lq) * PROJ + 1536 + lh * 64 + 8 * i); }
#pragma unroll
          for (int h = 0; h < 4; ++h) bias[h] = spb[h * 128 + p0 + fr];
#pragma unroll
          for (int h = 0; h < 4; ++h)
#pragma unroll
              for (int ks = 0; ks < 4; ++ks) { const bf16x8 wf = *(const bf16x8*)(SPW + ((size_t)(h * 128 + p0 + fr) * 128 + ks * 32 + 8 * fq));
#pragma unroll
                  for (int nt = 0; nt < 4; ++nt) { const int ct = h * 4 + nt; const bf16x8 vf = *(const LAS bf16x8*)(F.lds + (ct * 16 + fr) * VROW + (ks * 32 + 8 * fq) * 2);
                      acc[ct] = MFMA16(vf, wf, acc[ct]); } }
          float ssq = 0.f;
#pragma unroll
          for (int ct = 0; ct < 16; ++ct) { const float bs = bias[ct >> 2];
              f32x4 y; y[0] = bf_lo(uw[ct].x) * (acc[ct][0] + bs); y[1] = bf_hi(uw[ct].x) * (acc[ct][1] + bs); y[2] = bf_lo(uw[ct].y) * (acc[ct][2] + bs); y[3] = bf_hi(uw[ct].y) * (acc[ct][3] + bs);
              acc[ct] = y; ssq += (y[0] * y[0] + y[1] * y[1]) + (y[2] * y[2] + y[3] * y[3]); }
          ssq += __shfl_xor(ssq, 16); ssq += __shfl_xor(ssq, 32);
          const float rs = rsqrtf(ssq * (1.f / 256.f) + EPS);
#pragma unroll
          for (int ct = 0; ct < 16; ++ct) { u32x2 w; w.x = pk2(acc[ct][0] * rs, acc[ct][1] * rs); w.y = pk2(acc[ct][2] * rs, acc[ct][3] * rs); *(u32x2*)(yr + 768 + ct * 16 + 4 * fq) = w; }
        }
        __syncthreads();
    }
}
__device__ __forceinline__ void p_mix_pool(Ctx& F, int l) {
    const bf16* proj = (const bf16*)(F.ws + WS_PROJ); bf16* Y = (bf16*)(F.ws + WS_Y);
    const bf16* POOLT = (const bf16*)(F.ws + WS_TAB + TAB_L + (size_t)l * TAB_LSTRIDE + TAB_POOLT);
    const int lane = F.lane, fr = lane & 15, fq = lane >> 4;
    LAS unsigned char* reg = F.lds + F.wave * (32 * PTROW);
    const int gw = F.bid * NWAVES + F.wave, NGW = F.G * NWAVES;
    const u32x4 zero4 = (u32x4){0u, 0u, 0u, 0u};
    for (int item = gw; item < MTOK / 16; item += NGW) {
        const int m0 = item * 16, tp0 = m0 % SEQ;
        { u32x4 pv[16];
#pragma unroll
          for (int i = 0; i < 16; ++i) { const int r = 2 * i + (lane >> 5), pc = lane & 31, tt = tp0 + r - 8; const int gr = min(max(m0 + r - 8, 0), MTOK - 1);
              const u32x4 raw = *(const u32x4*)(proj + (size_t)gr * PROJ + 768 + pc * 8); pv[i] = (tt >= 0 && tt < SEQ) ? raw : zero4; }
#pragma unroll
          for (int i = 0; i < 16; ++i) { const int r = 2 * i + (lane >> 5), pc = lane & 31; *(LAS u32x4*)(reg + r * PTROW + pc * 16) = pv[i]; }
        }
        asm volatile("s_waitcnt lgkmcnt(0)" ::: "memory");
        const int t = tp0 + fr; bf16* yr = Y + (size_t)(m0 + fr) * DM;
        f32x4 acc[16];
#pragma unroll
        for (int i = 0; i < 16; ++i) acc[i] = (f32x4){0.f, 0.f, 0.f, 0.f};
        const LAS unsigned char* ptl = reg + fr * PTROW;
#pragma unroll
        for (int g = 0; g < 4; ++g) { const int half = 1 << g; const int lo = max(t - half, 0), hi = min(t + half, SEQ); const float inv = 1.0f / (float)(hi - lo);
#pragma unroll
            for (int ks = 0; ks < 2; ++ks) { const int chb = (g * 64 + ks * 32 + 8 * fq) * 2; float s[8];
#pragma unroll
                for (int e = 0; e < 8; ++e) s[e] = 0.f;
#pragma unroll
                for (int i = 0; i < 2 * half; ++i) { float f[8]; unpack8(*(const LAS u32x4*)(ptl + (8 + i - half) * PTROW + chb), f);
#pragma unroll
                    for (int e = 0; e < 8; ++e) s[e] += f[e]; }
                float sf[8]; unpack8(*(const LAS u32x4*)(ptl + 8 * PTROW + chb), sf);
#pragma unroll
                for (int e = 0; e < 8; ++e) s[e] = s[e] * inv - sf[e];
                const bf16x8 df = __builtin_bit_cast(bf16x8, pack8(s));
#pragma unroll
                for (int nt = 0; nt < 4; ++nt) { const bf16x8 pf = *(const bf16x8*)(POOLT + ((size_t)(g * 64 + nt * 16 + fr) * 64 + ks * 32 + 8 * fq));
                    acc[g * 4 + nt] = MFMA16(pf, df, acc[g * 4 + nt]); }
                asm volatile("" ::: "memory"); } }
        float ssq = 0.f;
#pragma unroll
        for (int ct = 0; ct < 16; ++ct) ssq += (acc[ct][0] * acc[ct][0] + acc[ct][1] * acc[ct][1]) + (acc[ct][2] * acc[ct][2] + acc[ct][3] * acc[ct][3]);
        ssq += __shfl_xor(ssq, 16); ssq += __shfl_xor(ssq, 32);
        const float rs = rsqrtf(ssq * (1.f / 256.f) + EPS);
#pragma unroll
        for (int ct = 0; ct < 16; ++ct) { u32x2 w; w.x = pk2(acc[ct][0] * rs, acc[ct][1] * rs); w.y = pk2(acc[ct][2] * rs, acc[ct][3] * rs); *(u32x2*)(yr + 256 + ct * 16 + 4 * fq) = w; }
        asm volatile("s_waitcnt lgkmcnt(0)" ::: "memory");
    }
}
__device__ __forceinline__ void p_mix_conv(Ctx& F, const Args& AR, int l) {
    const bf16* proj = (const bf16*)(F.ws + WS_PROJ); bf16* Y = (bf16*)(F.ws + WS_Y);
    const float* convw = AR.in[6] + l * 3 * 256;
    const int lane = F.lane, l32 = lane & 31, hw = lane >> 5, cch = 8 * l32;
    const int gw = F.bid * NWAVES + F.wave, NGW = F.G * NWAVES;
    const u32x4 zero4 = (u32x4){0u, 0u, 0u, 0u};
    float w0[8], w1[8], w2[8];
#pragma unroll
    for (int e = 0; e < 8; ++e) { w0[e] = convw[cch + e]; w1[e] = convw[256 + cch + e]; w2[e] = convw[512 + cch + e]; }
    for (int item = gw; item < MTOK / 16; item += NGW) {
        const int mb = item * 16 + 8 * hw, tq = mb % SEQ;
        const bf16* pc = proj + (size_t)mb * PROJ + cch; bf16* yc = Y + (size_t)mb * DM + cch;
        u32x4 bw[8], cv[10], zv[10];
#pragma unroll
        for (int i = 0; i < 8; ++i) bw[i] = *(const u32x4*)(pc + (size_t)i * PROJ);
#pragma unroll
        for (int i = 0; i < 10; ++i) { const int tt = tq + i - 1; const bool ok = tt >= 0 && tt < SEQ; const int gr = min(max(mb + i - 1, 0), MTOK - 1); const bf16* pq = proj + (size_t)gr * PROJ + cch;
            const u32x4 rc = *(const u32x4*)(pq + 256), rz = *(const u32x4*)(pq + 512); cv[i] = ok ? rc : zero4; zv[i] = ok ? rz : zero4; }
        float czp[8], czc[8], czn[8];
        { float a[8], b[8]; unpack8(cv[0], a); unpack8(zv[0], b);
#pragma unroll
          for (int e = 0; e < 8; ++e) czp[e] = a[e] * b[e];
          unpack8(cv[1], a); unpack8(zv[1], b);
#pragma unroll
          for (int e = 0; e < 8; ++e) czc[e] = a[e] * b[e]; }
#pragma unroll
        for (int i = 0; i < 8; ++i) { float a[8], b[8], y[8]; unpack8(cv[i + 2], a); unpack8(zv[i + 2], b);
#pragma unroll
            for (int e = 0; e < 8; ++e) czn[e] = a[e] * b[e];
            unpack8(bw[i], b); float ssq = 0.f;
#pragma unroll
            for (int e = 0; e < 8; ++e) { y[e] = b[e] * (w0[e] * czp[e] + w1[e] * czc[e] + w2[e] * czn[e]); ssq += y[e] * y[e]; }
            ssq += __shfl_xor(ssq, 1); ssq += __shfl_xor(ssq, 2); ssq += __shfl_xor(ssq, 4); ssq += __shfl_xor(ssq, 8); ssq += __shfl_xor(ssq, 16);
            const float rs = rsqrtf(ssq * (1.f / 256.f) + EPS);
#pragma unroll
            for (int e = 0; e < 8; ++e) { y[e] *= rs; czp[e] = czc[e]; czc[e] = czn[e]; }
            *(u32x4*)(yc + (size_t)i * DM) = pack8(y); }
    }
}
__device__ __forceinline__ void p_mix_f1(Ctx& F) {
    const bf16* proj = (const bf16*)(F.ws + WS_PROJ); f32x2* H = (f32x2*)(F.ws + WS_H); const bf16* TT = (const bf16*)(F.ws + WS_TAB + TAB_TT);
    const int lane = F.lane, fr = lane & 15, fq = lane >> 4;
    const int gw = F.bid * NWAVES + F.wave, NGW = F.G * NWAVES;
    bf16x8 tf[2][4];
#pragma unroll
    for (int ks = 0; ks < 2; ++ks)
#pragma unroll
        for (int nt = 0; nt < 4; ++nt) tf[ks][nt] = *(const bf16x8*)(TT + (nt * 16 + fr) * 64 + ks * 32 + 8 * fq);
    for (int item = gw; item < MTOK / 16; item += 2 * NGW) {
        bf16x8 ff[2][4][2];
#pragma unroll
        for (int it = 0; it < 2; ++it) { const int m = min(item + it * NGW, MTOK / 16 - 1) * 16 + fr; const bf16* pr = proj + (size_t)m * PROJ + 1024;
#pragma unroll
            for (int h = 0; h < 4; ++h)
#pragma unroll
                for (int ks = 0; ks < 2; ++ks) ff[it][h][ks] = *(const bf16x8*)(pr + h * 64 + ks * 32 + 8 * fq); }
#pragma unroll
        for (int it = 0; it < 2; ++it) { if (item + it * NGW >= MTOK / 16) break; const int m = (item + it * NGW) * 16 + fr, bb = m / SEQ, t = m % SEQ;
#pragma unroll
            for (int h = 0; h < 4; ++h) { f32x4 a4[4];
#pragma unroll
                for (int i = 0; i < 4; ++i) a4[i] = (f32x4){0.f, 0.f, 0.f, 0.f};
#pragma unroll
                for (int ks = 0; ks < 2; ++ks)
#pragma unroll
                    for (int nt = 0; nt < 4; ++nt) a4[nt] = MFMA16(tf[ks][nt], ff[it][h][ks], a4[nt]);
#pragma unroll
                for (int nt = 0; nt < 4; ++nt) { f32x2* hp = H + ((size_t)((bb * 4 + h) * 32 + 8 * nt + 2 * fq) * SEQ + t);
                    hp[0] = (f32x2){a4[nt][0], a4[nt][1]}; hp[SEQ] = (f32x2){a4[nt][2], a4[nt][3]}; } } }
    }
}

__device__ __forceinline__ f32x2 cmul(const f32x2 a, const f32x2 b) { return (f32x2){a.x * b.x - a.y * b.y, a.x * b.y + a.y * b.x}; }
__device__ __forceinline__ void dft4(f32x2& a0, f32x2& a1, f32x2& a2, f32x2& a3) {
    const f32x2 s02 = a0 + a2, d02 = a0 - a2, s13 = a1 + a3, d13 = a1 - a3; const f32x2 md = (f32x2){d13.y, -d13.x};
    a0 = s02 + s13; a1 = d02 + md; a2 = s02 - s13; a3 = d02 - md;
}
__device__ __forceinline__ void dft16(f32x2 (&u)[16]) {
#pragma unroll
    for (int q2 = 0; q2 < 4; ++q2) dft4(u[q2], u[4 + q2], u[8 + q2], u[12 + q2]);
    const float c1 = 0.92387953251128674f, s1 = 0.38268343236508977f, r = 0.70710678118654752f;
    const f32x2 W1 = (f32x2){c1, -s1}, W2 = (f32x2){r, -r}, W3 = (f32x2){s1, -c1}, W4 = (f32x2){0.f, -1.f}, W6 = (f32x2){-r, -r}, W9 = (f32x2){-c1, s1};
    u[5] = cmul(u[5], W1); u[6] = cmul(u[6], W2); u[7] = cmul(u[7], W3);
    u[9] = cmul(u[9], W2); u[10] = cmul(u[10], W4); u[11] = cmul(u[11], W6);
    u[13] = cmul(u[13], W3); u[14] = cmul(u[14], W6); u[15] = cmul(u[15], W9);
#pragma unroll
    for (int n1 = 0; n1 < 4; ++n1) dft4(u[4 * n1], u[4 * n1 + 1], u[4 * n1 + 2], u[4 * n1 + 3]);
}
__device__ __forceinline__ int PX(int i) { return i + (i >> 4); }
__device__ __forceinline__ void p_fft(Ctx& F) {
    LAS f32x2* X = (LAS f32x2*)F.lds; LAS f32x2* TWL = (LAS f32x2*)(F.lds + 69632);
    const f32x2* TW = (const f32x2*)(F.ws + WS_TAB + TAB_TW); const f32x2* H = (const f32x2*)(F.ws + WS_H); float* A = (float*)(F.ws + WS_A);
    const int tid = F.tid;
    for (int i = tid; i < 4096; i += NTHR) TWL[i] = TW[i];
    f32x2 pre[16];
    if (F.bid < BATCH * 4 * 32) {
#pragma unroll
        for (int q = 0; q < 16; ++q) pre[q] = H[(size_t)F.bid * SEQ + tid + NTHR * q]; }
    for (int colid = F.bid; colid < BATCH * 4 * 32; colid += F.G) {
        f32x2 u[16];
#pragma unroll
        for (int q = 0; q < 16; ++q) u[q] = pre[q];
        if (colid + F.G < BATCH * 4 * 32) {
#pragma unroll
            for (int q = 0; q < 16; ++q) pre[q] = H[(size_t)(colid + F.G) * SEQ + tid + NTHR * q]; }
        dft16(u);
        __syncthreads();
#pragma unroll
        for (int ri = 0; ri < 16; ++ri) X[PX(16 * tid + (ri >> 2) + 4 * (ri & 3))] = u[ri];
        __syncthreads();
#pragma unroll
        for (int ps = 0; ps < 2; ++ps) { const int Ns = ps ? 256 : 16, k = tid & (Ns - 1); const f32x2 w = TWL[ps ? 2 * k : 32 * k];
#pragma unroll
            for (int q = 0; q < 16; ++q) u[q] = X[PX(tid + NTHR * q)];
            f32x2 wq = w; u[1] = cmul(u[1], wq);
#pragma unroll
            for (int q = 2; q < 16; ++q) { wq = cmul(wq, w); u[q] = cmul(u[q], wq); }
            dft16(u);
            __syncthreads();
            const int j0 = ((tid - k) << 4) + k;
#pragma unroll
            for (int ri = 0; ri < 16; ++ri) X[PX(j0 + ((ri >> 2) + 4 * (ri & 3)) * Ns)] = u[ri];
            __syncthreads(); }
        const int bh = colid >> 5, col = colid & 31;
        if (col != 0) { float* dst = A + ((size_t)bh * 33 + col) * SEQ;
#pragma unroll
            for (int i = 0; i < 8; ++i) { const int j = tid + NTHR * i; const f32x2 a = X[PX(j)], b = cmul(X[PX(j + 4096)], TWL[j]); dst[j] = a.x + b.x; dst[j + 4096] = a.x - b.x; } }
        else {
            f32x2 z0[8], z1[8];
#pragma unroll
            for (int i = 0; i < 8; ++i) { const int j = tid + NTHR * i; const f32x2 a = X[PX(j)], b = cmul(X[PX(j + 4096)], TWL[j]); z0[i] = a + b; z1[i] = a - b; }
            __syncthreads();
#pragma unroll
            for (int i = 0; i < 8; ++i) { const int j = tid + NTHR * i; X[PX(j)] = z0[i]; X[PX(j + 4096)] = z1[i]; }
            __syncthreads();
            float* d0 = A + ((size_t)bh * 33) * SEQ; float* d32 = A + ((size_t)bh * 33 + 32) * SEQ;
#pragma unroll
            for (int i = 0; i < 16; ++i) { const int k = tid + NTHR * i, km = (SEQ - k) & (SEQ - 1); const f32x2 a = X[PX(k)], b = X[PX(km)]; d0[k] = 0.5f * (a.x + b.x); d32[k] = 0.5f * (a.y + b.y); } }
    }
}

__device__ __forceinline__ void p_fourier_out(Ctx& F, int l) {
    const float* A = (const float*)(F.ws + WS_A); bf16* Y = (bf16*)(F.ws + WS_Y);
    const bf16* FWT = (const bf16*)(F.ws + WS_TAB + TAB_L + (size_t)l * TAB_LSTRIDE + TAB_FWT);
    const int lane = F.lane, fr = lane & 15, fq = lane >> 4;
    const int gw = F.bid * NWAVES + F.wave, NGW = F.G * NWAVES;
    for (int item = gw; item < MTOK / 16; item += NGW) {
        const int m0 = item * 16, bb = m0 / SEQ, k = (m0 % SEQ) + fr, km = (SEQ - k) & (SEQ - 1);
        f32x4 acc[16];
#pragma unroll
        for (int i = 0; i < 16; ++i) acc[i] = (f32x4){0.f, 0.f, 0.f, 0.f};
#pragma unroll
        for (int h = 0; h < 4; ++h) { const float* Ab = A + (size_t)(bb * 4 + h) * 33 * SEQ;
#pragma unroll
            for (int ks = 0; ks < 2; ++ks) { float s[8];
#pragma unroll
                for (int e = 0; e < 8; ++e) { const int jp = ks * 32 + 8 * fq + e; s[e] = (jp <= 32) ? Ab[(size_t)jp * SEQ + k] : Ab[(size_t)(64 - jp) * SEQ + km]; }
                const bf16x8 sf = __builtin_bit_cast(bf16x8, pack8(s));
#pragma unroll
                for (int nt = 0; nt < 4; ++nt) { const bf16x8 wf = *(const bf16x8*)(FWT + ((size_t)(h * 64 + nt * 16 + fr) * 64 + ks * 32 + 8 * fq));
                    acc[h * 4 + nt] = MFMA16(wf, sf, acc[h * 4 + nt]); } } }
        float ssq = 0.f;
#pragma unroll
        for (int ct = 0; ct < 16; ++ct) ssq += (acc[ct][0] * acc[ct][0] + acc[ct][1] * acc[ct][1]) + (acc[ct][2] * acc[ct][2] + acc[ct][3] * acc[ct][3]);
        ssq += __shfl_xor(ssq, 16); ssq += __shfl_xor(ssq, 32);
        const float rs = rsqrtf(ssq * (1.f / 256.f) + EPS);
        bf16* yr = Y + (size_t)(m0 + fr) * DM + 512;
#pragma unroll
        for (int ct = 0; ct < 16; ++ct) { u32x2 w; w.x = pk2(acc[ct][0] * rs, acc[ct][1] * rs); w.y = pk2(acc[ct][2] * rs, acc[ct][3] * rs); *(u32x2*)(yr + ct * 16 + 4 * fq) = w; }
    }
}

__device__ __forceinline__ void p_residual(Ctx& F, float* xout, const float* gain, bool last) {
    const bf16* MB = (const bf16*)(F.ws + WS_MB); const float* SS = (const float*)(F.ws + WS_SS); bf16* XB = (bf16*)(F.ws + WS_HB); float* RS = (float*)(F.ws + WS_RS);
    const int lane = F.lane, gw = F.bid * NWAVES + F.wave, NGW = F.G * NWAVES;
    constexpr int ER = 4;
    f32x4 g[2][2];
#pragma unroll
    for (int j = 0; j < 2; ++j) { g[j][0] = *(const f32x4*)(gain + 8 * lane + 512 * j); g[j][1] = *(const f32x4*)(gain + 8 * lane + 512 * j + 4); }
    for (int m0 = gw * ER; m0 < MTOK; m0 += NGW * ER) {
        u32x4 mw[ER][2], xw[ER][2]; float sp[ER];
#pragma unroll
        for (int r = 0; r < ER; ++r) { const size_t m = (size_t)m0 + r; sp[r] = SS[m * 16 + (lane & 15)];
#pragma unroll
            for (int j = 0; j < 2; ++j) { mw[r][j] = *(const u32x4*)(MB + m * DM + 8 * lane + 512 * j); xw[r][j] = *(const u32x4*)(XB + m * DM + 8 * lane + 512 * j); } }
#pragma unroll
        for (int r = 0; r < ER; ++r) { const size_t m = (size_t)m0 + r; float q = sp[r];
            q += __shfl_xor(q, 1); q += __shfl_xor(q, 2); q += __shfl_xor(q, 4); q += __shfl_xor(q, 8);
            const float rsm = rsqrtf(q * (1.f / DM) + EPS);
            float v[2][8]; float s = 0.f;
#pragma unroll
            for (int j = 0; j < 2; ++j) { float mf[8], xf[8]; unpack8(mw[r][j], mf); unpack8(xw[r][j], xf);
#pragma unroll
                for (int e = 0; e < 8; ++e) { const float gg = e < 4 ? g[j][0][e & 3] : g[j][1][e & 3]; v[j][e] = xf[e] + mf[e] * rsm * gg; s += v[j][e] * v[j][e]; } }
            if (!last) { const float rs = rsqrtf(wave_sum(s) * (1.f / DM) + EPS); if (lane == 0) RS[m] = rs;
#pragma unroll
                for (int j = 0; j < 2; ++j) *(u32x4*)(XB + m * DM + 8 * lane + 512 * j) = pack8(v[j]); }
            else {
#pragma unroll
                for (int j = 0; j < 2; ++j) { f32x4* xo = (f32x4*)(xout + m * DM + 8 * lane + 512 * j); xo[0] = (f32x4){v[j][0], v[j][1], v[j][2], v[j][3]}; xo[1] = (f32x4){v[j][4], v[j][5], v[j][6], v[j][7]}; } }
        }
    }
}

#define RLX_AGENT __ATOMIC_RELAXED, __HIP_MEMORY_SCOPE_AGENT
#define XB_TMO      128
#define XB_XCNT(j)  (256  + 64 * (j))
#define XB_XSUB(j)  (1280 + 64 * (j))
#define XB_XGEN(j)  (2304 + 64 * (j))
#define XB_TOP      3328
#define XB_TOPGEN   3392
#define XCD_BAR_WORDS 3456
#define XB_SPIN_CAP (1u << 18)

__device__ __forceinline__ unsigned xb_ld(unsigned* p)              { return __hip_atomic_load(p, __ATOMIC_RELAXED, __HIP_MEMORY_SCOPE_AGENT); }
__device__ __forceinline__ unsigned xb_add(unsigned* p, unsigned v) { return __hip_atomic_fetch_add(p, v, __ATOMIC_RELAXED, __HIP_MEMORY_SCOPE_AGENT); }
__device__ __forceinline__ unsigned xb_xcc_id() { return (unsigned)__builtin_amdgcn_s_getreg((3 << 11) | 20) & 0xFu; }
#define XB_SPIN(cond, bar) do { unsigned _sp = 0; while (cond) { __builtin_amdgcn_s_sleep(1); \
    if ((++_sp & 255u) == 0u) { if (xb_ld(&(bar)[XB_TMO])) break; if (_sp > XB_SPIN_CAP) { atomicAdd(&(bar)[XB_TMO], 1u); break; } } } } while (0)

struct XcdBarrier {
    unsigned* bar; unsigned x;
    volatile LAS unsigned* st;
};

__device__ __forceinline__ XcdBarrier xcd_barrier_post(unsigned* bar, volatile LAS unsigned* st) {
    XcdBarrier b; b.bar = bar; b.x = xb_xcc_id(); b.st = st;
    if (threadIdx.x == 0) (void)xb_add(&bar[XB_XCNT(b.x)], 1u);
    return b;
}
__device__ __forceinline__ void xcd_barrier_complete(unsigned* bar, unsigned x, unsigned& nloc, unsigned& nx) {
    const unsigned G = gridDim.x * gridDim.y * gridDim.z;
    unsigned sum, cnt, mine, sp = 0u;
    for (;;) {
        sum = 0u; cnt = 0u; mine = 0u;
#pragma unroll
        for (unsigned j = 0; j < 16; ++j) { const unsigned c = xb_ld(&bar[XB_XCNT(j)]); sum += c; cnt += (c > 0u) ? 1u : 0u; mine = (j == x) ? c : mine; }
        if (sum == G) break;
        __builtin_amdgcn_s_sleep(1);
        if ((++sp & 255u) == 0u) { if (xb_ld(&bar[XB_TMO])) break; if (sp > XB_SPIN_CAP) { atomicAdd(&bar[XB_TMO], 1u); break; } }
    }
    nloc = mine > 0u ? mine : 1u; nx = cnt > 0u ? cnt : 1u;
}

__device__ __forceinline__ void xcd_barrier(const XcdBarrier& b) {
    asm volatile("s_waitcnt vmcnt(0)" ::: "memory");
    __syncthreads();
    if (threadIdx.x == 0) {
        unsigned* bar = b.bar;
        __builtin_amdgcn_s_waitcnt(0);
        unsigned nloc = b.st[0], nx = b.st[1];
        if (nloc == 0u) { xcd_barrier_complete(bar, b.x, nloc, nx); b.st[0] = nloc; b.st[1] = nx; }
        const unsigned old = xb_add(&bar[XB_XSUB(b.x)], 1u);
        const unsigned gen = old / nloc;
        if (old + 1u == (gen + 1u) * nloc) {
            __builtin_amdgcn_fence(__ATOMIC_RELEASE, "agent");
            asm volatile("s_waitcnt vmcnt(0)" ::: "memory");
            const unsigned og = xb_add(&bar[XB_TOP], 1u);
            const unsigned tg = og / nx;
            if (og + 1u == (tg + 1u) * nx) xb_add(&bar[XB_TOPGEN], 1u);
            else XB_SPIN(xb_ld(&bar[XB_TOPGEN]) == tg, bar);
            __builtin_amdgcn_fence(__ATOMIC_ACQUIRE, "agent");
            xb_add(&bar[XB_XGEN(b.x)], 1u);
            asm volatile("s_waitcnt vmcnt(0)" ::: "memory");
        } else {
            XB_SPIN(xb_ld(&bar[XB_XGEN(b.x)]) == gen, bar);
            __builtin_amdgcn_fence(__ATOMIC_ACQUIRE, "agent");
            asm volatile("s_waitcnt vmcnt(0)" ::: "memory");
        }
    }
    __syncthreads();
}

__global__ void __launch_bounds__(NTHR, 2) mk_fwd(Args args) {
    extern __shared__ __attribute__((aligned(16))) unsigned char lds_raw[];
#define MKCTX() Ctx F; { int t_ = threadIdx.x; asm volatile("" : "+v"(t_)); int b_ = blockIdx.x, g_ = gridDim.x; asm volatile("" : "+s"(b_), "+s"(g_)); \
        F.lds = (LAS unsigned char*)lds_raw; F.tid = t_; F.lane = t_ & 63; F.wave = __builtin_amdgcn_readfirstlane(t_ >> 6); F.G = g_; F.bid = b_; F.ws = args.ws; }
    const int lo = args.ph_lo, hi = args.ph_hi;
#define IN(k) (lo <= (k) && (k) < hi)
#ifndef PH_MASK
#define PH_MASK 0x3ff
#endif
#define EN(b) ((PH_MASK >> (b)) & 1)
#ifndef REP_MASK
#define REP_MASK 0
#endif
#define REPS(b) (1 + ((REP_MASK >> (b)) & 1))
#define SEAM(k) do { if (IN(k) && IN((k) + 1)) xcd_barrier(bar); } while (0)
#define WSP(T, off) ((T*)(args.ws + (off)))
    unsigned* const barw = (unsigned*)(args.ws + WS_CTL);
    volatile LAS unsigned* const bst = (volatile LAS unsigned*)((LAS unsigned char*)lds_raw + 149552);
    if (threadIdx.x < 2) bst[threadIdx.x] = 0u;
    if (IN(0) && blockIdx.x == 0) for (int i = threadIdx.x; i < CW_WORDS; i += NTHR) __hip_atomic_store(barw + i, 0u, RLX_AGENT);
    if (IN(0) && EN(9)) for (int rep_ = 0; rep_ < REPS(9); ++rep_) { MKCTX(); p_prologue(F, args); }
    XcdBarrier bar; bar.bar = barw; bar.x = 0; bar.st = bst;
    if (IN(0) && IN(1)) { cg::this_grid().sync(); bar = xcd_barrier_post(barw, bst); }
#pragma unroll 1
    for (int l = 0; l < DEPTH; ++l) {
        const int pb = 1 + 9 * l;
        if (IN(pb + 0) && EN(0)) for (int rep_ = 0; rep_ < REPS(0); ++rep_) { MKCTX(); pg8::Gemm g{WSP(const bf16, WS_HB), WSP(const bf16, WS_W + (size_t)l * W_LSTRIDE + W_IN), MTOK, PROJ, DM, 0}; pg8::StaticOrder S; S.init(MTOK, PROJ, F.G, F.bid); pg8::EpiPlain E{WSP(bf16, WS_PROJ), PROJ, WSP(const float, WS_RS), F.lds + 131072};
            pg8::gemm_phase<pg8::EpiPlain, pg8::StaticOrder, true, true>(F.lds, g, S, E); }
        SEAM(pb + 0);
        if (IN(pb + 1) && EN(1)) for (int rep_ = 0; rep_ < REPS(1); ++rep_) {
            for (int r_ = 0; r_ < 1 + (M1_REP & 1); ++r_) { MKCTX(); p_mix_conv(F, args, l); }
            for (int r_ = 0; r_ < 1 + ((M1_REP >> 1) & 1); ++r_) { MKCTX(); p_mix_f1(F); }
            for (int r_ = 0; r_ < 1 + ((M1_REP >> 2) & 1); ++r_) { MKCTX(); p_mix_pool(F, l); }
            __syncthreads();
            for (int r_ = 0; r_ < 1 + ((M1_REP >> 3) & 1); ++r_) { MKCTX(); p_mix_gmlp(F, args, l); } }
        SEAM(pb + 1);
        if (IN(pb + 2) && EN(2)) for (int rep_ = 0; rep_ < REPS(2); ++rep_) { MKCTX(); p_fft(F); }
        SEAM(pb + 2);
        if (IN(pb + 3) && EN(3)) for (int rep_ = 0; rep_ < REPS(3); ++rep_) { MKCTX(); p_fourier_out(F, l); }
        SEAM(pb + 3);
        if (IN(pb + 4) && EN(4)) for (int rep_ = 0; rep_ < REPS(4); ++rep_) { MKCTX(); pg8::Gemm g{WSP(const bf16, WS_Y), WSP(const bf16, WS_W + (size_t)l * W_LSTRIDE + W_OUT), MTOK, DM, DM, 0}; pg8::StaticOrder S; S.init(MTOK, DM, F.G, F.bid);
#if FUSE_E
            pg8::EpiFused E{WSP(bf16, WS_HB), args.in[2] + l * DM, WSP(unsigned, WS_XS), WSP(unsigned, WS_P2), WSP(float, WS_RS), barw + CW_CNT + (4 * l + 0) * CW_CNT_SET, barw + CW_CNT + (4 * l + 1) * CW_CNT_SET, args.out, 0, F.lds + 131072};
            pg8::gemm_phase<pg8::EpiFused, pg8::StaticOrder, true, true>(F.lds, g, S, E); }
#else
            pg8::EpiSS E{WSP(bf16, WS_MB), DM, WSP(float, WS_SS)};
            pg8::gemm_phase<pg8::EpiSS, pg8::StaticOrder, true, true>(F.lds, g, S, E); }
#endif
        SEAM(pb + 4);
#if !FUSE_E
        if (IN(pb + 5) && EN(5)) for (int rep_ = 0; rep_ < REPS(5); ++rep_) { MKCTX(); p_residual(F, args.out, args.in[2] + l * DM, false); }
        SEAM(pb + 5);
#endif
        if (IN(pb + 6) && EN(6)) for (int rep_ = 0; rep_ < REPS(6); ++rep_) { MKCTX(); pg8::Gemm g{WSP(const bf16, WS_HB), WSP(const bf16, WS_W + (size_t)l * W_LSTRIDE + W_GU), MTOK, NGU, DM, 0}; pg8::StaticOrder S; S.init(MTOK, NGU, F.G, F.bid); pg8::EpiSwiGLU E{WSP(bf16, WS_ACT), FF, WSP(const float, WS_RS)};
            pg8::gemm_phase<pg8::EpiSwiGLU, pg8::StaticOrder, true, true>(F.lds, g, S, E); }
        SEAM(pb + 6);
        if (IN(pb + 7) && EN(7)) for (int rep_ = 0; rep_ < REPS(7); ++rep_) { MKCTX(); pg8::Gemm g{WSP(const bf16, WS_ACT), WSP(const bf16, WS_W + (size_t)l * W_LSTRIDE + W_DN), MTOK, DM, FF, 1}; pg8::StaticOrder S; S.init(MTOK, DM, F.G, F.bid);
#if FUSE_E
            pg8::EpiFused E{WSP(bf16, WS_HB), args.in[4] + l * DM, WSP(unsigned, WS_XS), WSP(unsigned, WS_P2), WSP(float, WS_RS), barw + CW_CNT + (4 * l + 2) * CW_CNT_SET, barw + CW_CNT + (4 * l + 3) * CW_CNT_SET, args.out, (l + 1 == DEPTH) ? 1 : 0, F.lds + 131072};
            pg8::gemm_phase<pg8::EpiFused, pg8::StaticOrder, true, true>(F.lds, g, S, E); }
#else
            pg8::EpiSS E{WSP(bf16, WS_MB), DM, WSP(float, WS_SS)};
            pg8::gemm_phase<pg8::EpiSS, pg8::StaticOrder, true, true>(F.lds, g, S, E); }
#endif
#if FUSE_E
        if (l + 1 < DEPTH) SEAM(pb + 7);
#else
        SEAM(pb + 7);
        if (IN(pb + 8) && EN(8)) for (int rep_ = 0; rep_ < REPS(8); ++rep_) { MKCTX(); p_residual(F, args.out, args.in[4] + l * DM, l + 1 == DEPTH); }
        SEAM(pb + 8);
#endif
    }
#undef IN
#undef SEAM
#undef WSP
}

extern "C" void kernel_launch(void* const* d_in, const int* in_sizes, int n_in, void* d_out, int out_size, void* d_ws, size_t ws_size, hipStream_t stream) {
    static int grid = 0;
    if (grid == 0) {
        if (n_in != 17 || in_sizes[0] != MTOK * DM || out_size != MTOK * DM || ws_size < WS_END) { fprintf(stderr, "kernel_launch: unexpected shapes (n_in %d, in0 %d, out %d, ws %zu)\n", n_in, n_in > 0 ? in_sizes[0] : -1, out_size, ws_size); grid = -1; return; }
        int dev = 0, cus = 0, per_cu = 0;
        if (hipGetDevice(&dev) != hipSuccess || hipDeviceGetAttribute(&cus, hipDeviceAttributeMultiprocessorCount, dev) != hipSuccess) { grid = -1; return; }
        if (hipFuncSetAttribute((const void*)mk_fwd, hipFuncAttributeMaxDynamicSharedMemorySize, LDS_BYTES) != hipSuccess) { fprintf(stderr, "kernel_launch: hipFuncSetAttribute failed\n"); grid = -1; return; }
        if (hipOccupancyMaxActiveBlocksPerMultiprocessor(&per_cu, (const void*)mk_fwd, NTHR, LDS_BYTES) != hipSuccess || per_cu < 1) { fprintf(stderr, "kernel_launch: occupancy query says %d\n", per_cu); per_cu = 1; }
        (void)hipGetLastError();
        grid = cus * 1;
        fprintf(stderr, "kernel_launch: grid %d (cus %d, per_cu %d)\n", grid, cus, per_cu);
    }
    if (grid < 0) return;
    Args a{};
    for (int i = 0; i < 17; ++i) a.in[i] = (const float*)d_in[i];
    a.out = (float*)d_out; a.ws = (unsigned char*)d_ws;
#if MK_SINGLE
    a.ph_lo = 0; a.ph_hi = NPHASE;
    void* kargs[] = {&a};
    hipError_t e = hipLaunchCooperativeKernel((const void*)mk_fwd, dim3(grid), dim3(NTHR), kargs, LDS_BYTES, stream);
    if (e != hipSuccess) fprintf(stderr, "kernel_launch: cooperative launch failed: %s (grid %d)\n", hipGetErrorString(e), grid);
#else
    for (int ph = 0; ph < NPHASE; ++ph) { a.ph_lo = ph; a.ph_hi = ph + 1; hipLaunchKernelGGL(mk_fwd, dim3(grid), dim3(NTHR), LDS_BYTES, stream, a); }
#endif
}
```
